# Optimizing an MI355X kernel written in HIP

```python
import jax, jax.numpy as jnp
from jax import lax
import numpy as np

D_MODEL = 1024
BATCH = 8
SEQ = 4096
DEPTH = 1

GLA_HEADS = 4
GLA_V = D_MODEL // 2
GLA_DV = GLA_V // GLA_HEADS
GLA_DK = GLA_DV // 2
GLA_QK = GLA_HEADS * GLA_DK
GLA_GATE_RANK = 16
GLA_GATE_NORMALIZER = 16.0
HGRN_HEADS = 4
HGRN_V = D_MODEL - GLA_V
HGRN_DV = HGRN_V // HGRN_HEADS
HGRN_DK = 128
HGRN_K = HGRN_HEADS * HGRN_DK
MIX_WIDTH = GLA_V + HGRN_V
CHUNK = 64
D_FF = 4 * D_MODEL
N_MOD = 6
EPS = 1e-6

IN_SPLITS = (GLA_QK, GLA_QK, GLA_V, GLA_GATE_RANK, GLA_V,
             HGRN_K, HGRN_K, HGRN_V, HGRN_V)
IN_WIDTH = sum(IN_SPLITS)
IN_OFFSETS = [int(o) for o in np.cumsum(IN_SPLITS)[:-1]]

kernel_name = "hymba_style_gla_hgrn2_adaln_layer"


def rms_norm(x, gain=None):
    xf = x.astype(jnp.float32)
    y = xf * lax.rsqrt(jnp.mean(xf * xf, axis=-1, keepdims=True) + EPS)
    if gain is not None:
        y = y * gain.astype(jnp.float32)
    return y.astype(x.dtype)


def modulate(h, shift, scale):
    return h * (1.0 + scale[:, None, :]) + shift[:, None, :]


def split_heads(t, n_heads):
    b, s, w = t.shape
    return t.reshape(b, s, n_heads, w // n_heads).transpose(0, 2, 1, 3)


def merge_heads(t):
    b, h, s, d = t.shape
    return t.transpose(0, 2, 1, 3).reshape(b, s, h * d)


def chunk_gated_linear_attention(q, k, v, log_a, chunk):
    b, h, s, dk = q.shape
    dv = v.shape[-1]
    n = s // chunk
    q = q.reshape(b, h, n, chunk, dk)
    k = k.reshape(b, h, n, chunk, dk)
    v = v.reshape(b, h, n, chunk, dv)
    cum = jnp.cumsum(log_a.reshape(b, h, n, chunk, dk), axis=3)
    cum_mid = cum[:, :, :, chunk // 2 - 1:chunk // 2, :]
    cum_last = cum[:, :, :, chunk - 1:chunk, :]
    q_rel = q * jnp.exp(cum - cum_mid)
    k_rel = k * jnp.exp(cum_mid - cum)
    causal = jnp.tril(jnp.ones((chunk, chunk), dtype=bool))
    scores = jnp.where(causal, jnp.einsum('bhncd,bhnsd->bhncs', q_rel, k_rel), 0.0)
    o_intra = jnp.einsum('bhncs,bhnse->bhnce', scores, v)
    k_to_end = k * jnp.exp(cum_last - cum)
    chunk_update = jnp.einsum('bhncd,bhnce->bhnde', k_to_end, v)
    chunk_decay = jnp.exp(cum_last[:, :, :, 0, :])

    def step(state, inp):
        decay, update = inp
        return decay[..., None] * state + update, state

    state0 = jnp.zeros((b, h, dk, dv), dtype=q.dtype)
    _, states_prev = lax.scan(step, state0,
                              (jnp.moveaxis(chunk_decay, 2, 0), jnp.moveaxis(chunk_update, 2, 0)))
    states_prev = jnp.moveaxis(states_prev, 0, 2)
    o_inter = jnp.einsum('bhncd,bhnde->bhnce', q * jnp.exp(cum), states_prev)
    return (o_intra + o_inter).reshape(b, h, s, dv)


def hybrid_mixer(h, layer, w_in, gla_gate_w2, gla_gate_b2, gla_norm_g,
                 hgrn_lb_logits, hgrn_norm_g, w_out):
    f32 = jnp.float32
    proj = h @ w_in
    gq, gk, gv, g_lr, g_gate, hq, hf, hi, h_gate = jnp.split(proj, IN_OFFSETS, axis=-1)

    gate_logits = (g_lr @ gla_gate_w2 + gla_gate_b2).astype(f32)
    log_a_gla = jax.nn.log_sigmoid(gate_logits) / GLA_GATE_NORMALIZER
    o_gla = chunk_gated_linear_attention(
        split_heads(gq.astype(f32), GLA_HEADS) * (GLA_DK ** -0.5),
        split_heads(gk.astype(f32), GLA_HEADS),
        split_heads(gv.astype(f32), GLA_HEADS),
        split_heads(log_a_gla, GLA_HEADS), CHUNK)
    o_gla = merge_heads(rms_norm(o_gla, gla_norm_g)).astype(h.dtype) * jax.nn.silu(g_gate)

    lb = jnp.cumsum(jax.nn.softmax(hgrn_lb_logits.astype(f32), axis=0), axis=0)[layer]
    forget = lb + (1.0 - lb) * jax.nn.sigmoid(hf.astype(f32))
    o_hgrn = chunk_gated_linear_attention(
        split_heads(jax.nn.silu(hq.astype(f32)), HGRN_HEADS),
        split_heads(1.0 - forget, HGRN_HEADS),
        split_heads(hi.astype(f32), HGRN_HEADS),
        split_heads(jnp.log(forget), HGRN_HEADS), CHUNK)
    o_hgrn = merge_heads(rms_norm(o_hgrn, hgrn_norm_g)).astype(h.dtype) * jax.nn.silu(h_gate)

    return jnp.concatenate([o_gla, o_hgrn], axis=-1) @ w_out


def setup_inputs(seed: int = 0) -> dict:
    key = jax.random.key(seed)
    ks = jax.random.split(key, 14)
    nrm = jax.random.normal
    f32 = jnp.float32
    return {
        "x": nrm(ks[0], (BATCH, SEQ, D_MODEL), f32),
        "c": nrm(ks[1], (BATCH, D_MODEL), f32),
        "w_ada": nrm(ks[2], (DEPTH, D_MODEL, N_MOD * D_MODEL), f32) * (D_MODEL ** -0.5),
        "b_ada": nrm(ks[3], (DEPTH, N_MOD * D_MODEL), f32) * 0.02,
        "w_in": nrm(ks[4], (DEPTH, D_MODEL, IN_WIDTH), f32) * (D_MODEL ** -0.5),
        "gla_gate_w2": nrm(ks[5], (DEPTH, GLA_GATE_RANK, GLA_QK), f32) * (GLA_GATE_RANK ** -0.5),
        "gla_gate_b2": nrm(ks[6], (DEPTH, GLA_QK), f32) * 0.02,
        "gla_norm_g": 1.0 + 0.02 * nrm(ks[7], (DEPTH, GLA_DV), f32),
        "hgrn_lb_logits": nrm(ks[8], (DEPTH + 1, HGRN_K), f32) * 0.1,
        "hgrn_norm_g": 1.0 + 0.02 * nrm(ks[9], (DEPTH, HGRN_DV), f32),
        "w_out": nrm(ks[10], (DEPTH, MIX_WIDTH, D_MODEL), f32) * (MIX_WIDTH ** -0.5),
        "w_mlp1": nrm(ks[11], (DEPTH, D_MODEL, D_FF), f32) * (D_MODEL ** -0.5),
        "w_mlp2": nrm(ks[12], (DEPTH, D_FF, D_MODEL), f32) * (D_FF ** -0.5),
        "final_norm_g": 1.0 + 0.02 * nrm(ks[13], (D_MODEL,), f32),
    }


def reference(x, c, w_ada, b_ada, w_in, gla_gate_w2, gla_gate_b2, gla_norm_g,
              hgrn_lb_logits, hgrn_norm_g, w_out, w_mlp1, w_mlp2, final_norm_g):
    cond = jax.nn.silu(c)
    for layer in range(DEPTH):
        mod = cond @ w_ada[layer] + b_ada[layer]
        shift1, scale1, gate1, shift2, scale2, gate2 = jnp.split(mod, N_MOD, axis=-1)
        h = modulate(rms_norm(x), shift1, scale1)
        y = hybrid_mixer(h, layer, w_in[layer], gla_gate_w2[layer], gla_gate_b2[layer],
                         gla_norm_g[layer], hgrn_lb_logits, hgrn_norm_g[layer], w_out[layer])
        x = x + gate1[:, None, :] * y
        h = modulate(rms_norm(x), shift2, scale2)
        y = jnp.square(jax.nn.relu(h @ w_mlp1[layer])) @ w_mlp2[layer]
        x = x + gate2[:, None, :] * y
    return rms_norm(x, final_norm_g)
```

```cpp
#include <hip/hip_runtime.h>
#include <hip/hip_cooperative_groups.h>
#include <cstdio>
#include <cstdint>
namespace pg8 {
#define PG8_LAS __attribute__((address_space(3)))
typedef unsigned short bf16_t;
typedef short bf16x8 __attribute__((ext_vector_type(8)));
typedef float f32x4 __attribute__((ext_vector_type(4)));
typedef unsigned u32x4 __attribute__((ext_vector_type(4)));
constexpr int BM = 256, BK = 64, HALF = 128, HTB = HALF * BK * 2  , STAGE_BYTES = 8 * HTB, NXCD = 8, WGM = 8;

__host__ __device__ __forceinline__ int lds_byte(int r, int c) { const int st = (r >> 4) * 2 + (c >> 5), rr = r & 15, cc = c & 31, ob = rr * 64 + cc * 2; return st * 1024 + (ob ^ (((ob >> 9) & 1) << 5)); }
__host__ __device__ __forceinline__ void stage_rc(int b, int& R, int& C) { const int st = b / 1024, sb = b % 1024, swz = sb ^ (((sb >> 9) & 1) << 5); R = (st >> 1) * 16 + swz / 64; C = (st & 1) * 32 + (swz % 64) / 2; }
__host__ __device__ __forceinline__ int perm32(int rho) { const int n = rho >> 4, i = rho & 15; return 8 * (i >> 2) + 4 * n + (i & 3); }

struct Unit { int pm, pn; };
struct Gemm { const bf16_t* A; const bf16_t* Bt; int M, N, K; };

struct StaticOrder {
    int nM, nN, nwg, G, c;
    __host__ __device__ void init(int M, int N, int G_, int c_) { nM = M / BM; nN = N / BM; nwg = nM * nN; G = G_; c = c_; }
    __host__ __device__ bool next(int i, Unit& u) const {
        const long L = (long)i * G + c; if (L >= nwg) return false;
        int wgid = (int)L; { const int q = nwg / NXCD, r = nwg % NXCD, xcd = wgid % NXCD, off = wgid / NXCD; wgid = (xcd < r ? xcd * (q + 1) : r * (q + 1) + (xcd - r) * q) + off; }
        const int nig = WGM * nN, gid = wgid / nig, fm = gid * WGM, gsz = (nM - fm) < WGM ? (nM - fm) : WGM;
        u.pm = fm + ((wgid % nig) % gsz); u.pn = (wgid % nig) / gsz; return true;
    }
    __device__ __forceinline__ void a_ready(const Unit&) const {}
    __device__ __forceinline__ void done(const Unit&) const {}
};

}
namespace pg8 {
typedef float f32x2c __attribute__((ext_vector_type(2)));
typedef __bf16 bf16x2c __attribute__((ext_vector_type(2)));
__device__ __forceinline__ unsigned cvt_pk_bf16(float lo, float hi) { const bf16x2c r = __builtin_convertvector((f32x2c){lo, hi}, bf16x2c); return __builtin_bit_cast(unsigned, r); }
typedef unsigned u32x4 __attribute__((ext_vector_type(4)));
__device__ __forceinline__ float fsigmoid(float x) { return __builtin_amdgcn_rcpf(1.0f + __expf(-x)); }
struct EpiProj {
    static constexpr bool PERM = true, AFTER_DRAIN = false;
    bf16_t* O; int ldc; const float* b2; const float* lb;
    __device__ __forceinline__ void operator()(const f32x4 (&acc)[2][2][4][2], const Unit& u, int wr, int wc, int fr, int fq) const {
        const int pn = u.pn;
        const int mode = (pn == 0) ? 0 : (pn == 2) ? 2 : (pn == 5 || pn == 6 || pn == 7 || pn == 8 || pn >= 13) ? 3 : (pn == 9 || pn == 10) ? 4 : 1;
        const int row0 = u.pm * BM + wr * 64 + fr; const int col0 = pn * BM + wc * 32 + 8 * fq;
        f32x4 av[2][2];
#pragma unroll
        for (int bj = 0; bj < 2; ++bj)
#pragma unroll
            for (int n = 0; n < 2; ++n) {
                if (mode == 2) av[bj][n] = *(const f32x4*)(b2 + (col0 - 512) + bj * HALF + 4 * n);
                else if (mode == 4) av[bj][n] = *(const f32x4*)(lb + (col0 - 2304) + bj * HALF + 4 * n);
                else av[bj][n] = (f32x4){0.f, 0.f, 0.f, 0.f};
            }
#pragma unroll
        for (int ai = 0; ai < 2; ++ai)
#pragma unroll
            for (int m = 0; m < 4; ++m) { bf16_t* rowp = O + (size_t)(row0 + ai * HALF + m * 16) * ldc + col0;
#pragma unroll
                for (int bj = 0; bj < 2; ++bj) { f32x4 v[2] = {acc[ai][bj][m][0], acc[ai][bj][m][1]};
#pragma unroll
                    for (int n = 0; n < 2; ++n)
#pragma unroll
                        for (int j = 0; j < 4; ++j) { float x = v[n][j];
                            if (mode == 0) x *= 0.125f;
                            else if (mode == 2) { x += av[bj][n][j]; x = (fminf(x, 0.f) - __logf(1.0f + __expf(-fabsf(x)))) * 0.0625f; }
                            else if (mode == 3) x = x * fsigmoid(x);
                            else if (mode == 4) { const float l = av[bj][n][j]; x = __logf(l + (1.0f - l) * fsigmoid(x)); }
                            v[n][j] = x; }
                    u32x4 w; w.x = cvt_pk_bf16(v[0][0], v[0][1]); w.y = cvt_pk_bf16(v[0][2], v[0][3]); w.z = cvt_pk_bf16(v[1][0], v[1][1]); w.w = cvt_pk_bf16(v[1][2], v[1][3]);
                    *(u32x4*)(rowp + bj * HALF) = w; } }
    }
};
struct EpiRelu2 {
    static constexpr bool PERM = true, AFTER_DRAIN = false;
    bf16_t* O; int ldc;
    __device__ __forceinline__ void operator()(const f32x4 (&acc)[2][2][4][2], const Unit& u, int wr, int wc, int fr, int fq) const {
        const int row0 = u.pm * BM + wr * 64 + fr; const int col0 = u.pn * BM + wc * 32 + 8 * fq;
#pragma unroll
        for (int ai = 0; ai < 2; ++ai)
#pragma unroll
            for (int m = 0; m < 4; ++m) { bf16_t* rowp = O + (size_t)(row0 + ai * HALF + m * 16) * ldc + col0;
#pragma unroll
                for (int bj = 0; bj < 2; ++bj) { f32x4 v0 = acc[ai][bj][m][0], v1 = acc[ai][bj][m][1];
#pragma unroll
                    for (int j = 0; j < 4; ++j) { const float a = fmaxf(v0[j], 0.f), b = fmaxf(v1[j], 0.f); v0[j] = a * a; v1[j] = b * b; }
                    u32x4 w; w.x = cvt_pk_bf16(v0[0], v0[1]); w.y = cvt_pk_bf16(v0[2], v0[3]); w.z = cvt_pk_bf16(v1[0], v1[1]); w.w = cvt_pk_bf16(v1[2], v1[3]);
                    *(u32x4*)(rowp + bj * HALF) = w; } }
    }
};
struct EpiRes {
    static constexpr bool PERM = false, AFTER_DRAIN = false;
    const float* base; float* out; int ldc; const float* gate; int gate_ld; int rows_per_batch;
    __device__ __forceinline__ void operator()(const f32x4 (&acc)[2][2][4][2], const Unit& u, int wr, int wc, int fr, int fq) const {
        const int row0 = u.pm * BM + wr * 64 + fr; const int col0 = u.pn * BM + wc * 32 + 4 * fq;
        const float* g = gate + (size_t)((u.pm * BM) / rows_per_batch) * gate_ld + col0;
        f32x4 gv[2][2];
#pragma unroll
        for (int bj = 0; bj < 2; ++bj)
#pragma unroll
            for (int n = 0; n < 2; ++n) gv[bj][n] = *(const f32x4*)(g + bj * HALF + n * 16);
#pragma unroll
        for (int ai = 0; ai < 2; ++ai)
#pragma unroll
            for (int m = 0; m < 4; ++m) { const size_t off = (size_t)(row0 + ai * HALF + m * 16) * ldc + col0;
#pragma unroll
                for (int bj = 0; bj < 2; ++bj)
#pragma unroll
                    for (int n = 0; n < 2; ++n) { const f32x4 bs = *(const f32x4*)(base + off + bj * HALF + n * 16);
                        *(f32x4*)(out + off + bj * HALF + n * 16) = bs + gv[bj][n] * acc[ai][bj][m][n]; } }
    }
};
}
namespace pg8 {
template <class Epi, class Sched, bool ALIGN_EPI = false, bool SP2 = false>
__device__ __forceinline__ void gemm_phase(PG8_LAS unsigned char* lds, const Gemm g, const Sched& S, const Epi& E) {
    const int tid = threadIdx.x, wid = __builtin_amdgcn_readfirstlane(tid >> 6), lane = tid & 63, wr = wid >> 2, wc = wid & 3, fr = lane & 15, fq = lane >> 4;
    const int K = g.K, nt = K / BK;
    unsigned voffA[2], voffB[2];
#pragma unroll
    for (int i = 0; i < 2; ++i) { int R, C; stage_rc(tid * 16 + i * 8192, R, C); const int Rb = Epi::PERM ? ((R & ~31) + perm32(R & 31)) : R;
        voffA[i] = (unsigned)(R * K + C) * 2u; voffB[i] = (unsigned)(Rb * K + C) * 2u; }
    const size_t kstep = (size_t)(BK * 2);
    const size_t hstep = (size_t)HALF * K * 2;
    const size_t tstep = 2 * hstep;
    const unsigned ldsw = (unsigned)wid * 1024u;
    const int aoff = lds_byte(wr * 64 + fr, fq * 8), boff = lds_byte(wc * 32 + fr, fq * 8);
#define PG8_SA(b, h) (((b) * 2 + (h)) * HTB)
#define PG8_SB(b, h) ((4 + (b) * 2 + (h)) * HTB)
#define PG8_STAGE(bufoff, gbase, voff) do { _Pragma("unroll") for (int _i = 0; _i < 2; ++_i) \
        __builtin_amdgcn_global_load_lds((const unsigned*)((const char*)(gbase) + (voff)[_i]), (PG8_LAS unsigned*)(lds + (bufoff) + ldsw + _i * 8192), 16, 0, 0); } while (0)
#define PG8_LDA(dst, b, h) do { _Pragma("unroll") for (int m = 0; m < 4; ++m) _Pragma("unroll") for (int k = 0; k < 2; ++k) dst[m][k] = *(const PG8_LAS bf16x8*)(lds + PG8_SA(b, h) + aoff + m * 2048 + k * 1024); } while (0)
#define PG8_LDB(dst, b, h) do { _Pragma("unroll") for (int n = 0; n < 2; ++n) _Pragma("unroll") for (int k = 0; k < 2; ++k) dst[n][k] = *(const PG8_LAS bf16x8*)(lds + PG8_SB(b, h) + boff + n * 2048 + k * 1024); } while (0)
#define PG8_MMA(ai, bj, At, Bt) do { __builtin_amdgcn_s_setprio(1); _Pragma("unroll") for (int m = 0; m < 4; ++m) _Pragma("unroll") for (int n = 0; n < 2; ++n) _Pragma("unroll") for (int k = 0; k < 2; ++k) \
        acc[ai][bj][m][n] = __builtin_amdgcn_mfma_f32_16x16x32_bf16(Bt[n][k], At[m][k], acc[ai][bj][m][n], 0, 0, 0); __builtin_amdgcn_s_setprio(0); } while (0)
#define PG8_WAIT_V(n) asm volatile("s_waitcnt vmcnt(" #n ")" ::: "memory")
#define PG8_WAIT_L(n) asm volatile("s_waitcnt lgkmcnt(" #n ")" ::: "memory")
#define PG8_BAR __builtin_amdgcn_s_barrier()
#define PG8_SCHED __builtin_amdgcn_sched_barrier(0)
    Unit cur, nxt; int ui = 0;
    if (!S.next(0, cur)) return;
    f32x4 acc[2][2][4][2];
#pragma unroll
    for (int a = 0; a < 2; ++a)
#pragma unroll
        for (int b = 0; b < 2; ++b)
#pragma unroll
            for (int m = 0; m < 4; ++m)
#pragma unroll
                for (int n = 0; n < 2; ++n) acc[a][b][m][n] = (f32x4){0.f, 0.f, 0.f, 0.f};
    bf16x8 At[4][2], B0[2][2], B1[2][2];
    const char* cA = (const char*)g.A + (size_t)cur.pm * tstep; const char* cB = (const char*)g.Bt + (size_t)cur.pn * tstep;
    S.a_ready(cur);
    if constexpr (SP2) {
        PG8_STAGE(PG8_SB(0, 0), cB, voffB); PG8_STAGE(PG8_SB(0, 1), cB + hstep, voffB); PG8_STAGE(PG8_SA(0, 0), cA, voffA); PG8_STAGE(PG8_SA(0, 1), cA + hstep, voffA);
        if (wr == 1) PG8_BAR;
        PG8_WAIT_V(2); PG8_BAR;
        PG8_STAGE(PG8_SB(1, 0), cB + kstep, voffB); PG8_STAGE(PG8_SA(1, 0), cA + kstep, voffA); PG8_STAGE(PG8_SB(1, 1), cB + hstep + kstep, voffB);
        PG8_WAIT_V(6); PG8_BAR;
    } else {
        PG8_STAGE(PG8_SB(0, 0), cB, voffB); PG8_STAGE(PG8_SA(0, 0), cA, voffA); PG8_STAGE(PG8_SB(0, 1), cB + hstep, voffB); PG8_STAGE(PG8_SA(0, 1), cA + hstep, voffA);
        if (wr == 1) PG8_BAR;
        PG8_WAIT_V(4); PG8_BAR;
        PG8_STAGE(PG8_SB(1, 0), cB + kstep, voffB); PG8_STAGE(PG8_SA(1, 0), cA + kstep, voffA); PG8_STAGE(PG8_SB(1, 1), cB + hstep + kstep, voffB);
        PG8_WAIT_V(6); PG8_BAR;
    }
    for (;;) {
        const bool has_next = S.next(ui + 1, nxt);
        const char* nA = has_next ? (const char*)g.A + (size_t)nxt.pm * tstep : cA; const char* nB = has_next ? (const char*)g.Bt + (size_t)nxt.pn * tstep : cB;
        for (int t = 0; t < nt; t += 2) {
            const bool last = (t == nt - 2);
            const char* a1 = cA + (size_t)(t + 1) * kstep;
            const char* a2 = last ? nA : cA + (size_t)(t + 2) * kstep; const char* b2 = last ? nB : cB + (size_t)(t + 2) * kstep;
            const char* a3 = a2 + kstep; const char* b3 = b2 + kstep;
            if (last && has_next) S.a_ready(nxt);
            if constexpr (SP2) {
            PG8_LDB(B0, 0, 0); PG8_LDB(B1, 0, 1); PG8_SCHED; PG8_LDA(At, 0, 0); PG8_STAGE(PG8_SA(1, 1), a1 + hstep, voffA);
            PG8_WAIT_V(8); PG8_WAIT_L(0); PG8_BAR; PG8_MMA(0, 0, At, B0); PG8_MMA(0, 1, At, B1); PG8_BAR; PG8_SCHED;
            PG8_LDA(At, 0, 1); PG8_STAGE(PG8_SB(0, 0), b2, voffB); PG8_STAGE(PG8_SB(0, 1), b2 + hstep, voffB); PG8_STAGE(PG8_SA(0, 0), a2, voffA);
            PG8_WAIT_V(8); PG8_WAIT_L(0); PG8_BAR; PG8_MMA(1, 0, At, B0); PG8_MMA(1, 1, At, B1); PG8_BAR; PG8_SCHED;
            PG8_LDB(B0, 1, 0); PG8_LDB(B1, 1, 1); PG8_SCHED; PG8_LDA(At, 1, 0); PG8_STAGE(PG8_SA(0, 1), a2 + hstep, voffA);
            PG8_WAIT_V(8); PG8_WAIT_L(0); PG8_BAR; PG8_MMA(0, 0, At, B0); PG8_MMA(0, 1, At, B1); PG8_BAR; PG8_SCHED;
            PG8_LDA(At, 1, 1); PG8_STAGE(PG8_SB(1, 0), b3, voffB); PG8_STAGE(PG8_SB(1, 1), b3 + hstep, voffB); PG8_STAGE(PG8_SA(1, 0), a3, voffA);
            PG8_WAIT_V(8); PG8_WAIT_L(0); PG8_BAR; PG8_MMA(1, 0, At, B0); PG8_MMA(1, 1, At, B1); PG8_BAR; PG8_SCHED;
            } else {
            PG8_LDB(B0, 0, 0); PG8_SCHED; PG8_LDA(At, 0, 0); PG8_STAGE(PG8_SA(1, 1), a1 + hstep, voffA);
            PG8_WAIT_L(8); PG8_BAR; PG8_WAIT_L(0); PG8_MMA(0, 0, At, B0); PG8_BAR; PG8_SCHED;
            PG8_LDB(B1, 0, 1); PG8_STAGE(PG8_SB(0, 0), b2, voffB);
            PG8_BAR; PG8_WAIT_L(0); PG8_MMA(0, 1, At, B1); PG8_BAR;
            PG8_LDA(At, 0, 1); PG8_STAGE(PG8_SA(0, 0), a2, voffA);
            PG8_BAR; PG8_WAIT_L(0); PG8_MMA(1, 0, At, B0); PG8_BAR; PG8_SCHED;
            PG8_STAGE(PG8_SB(0, 1), b2 + hstep, voffB);
            PG8_WAIT_V(6); PG8_BAR; PG8_MMA(1, 1, At, B1); PG8_BAR;
            PG8_LDB(B0, 1, 0); PG8_SCHED; PG8_LDA(At, 1, 0); PG8_STAGE(PG8_SA(0, 1), a2 + hstep, voffA);
            PG8_WAIT_L(8); PG8_BAR; PG8_WAIT_L(0); PG8_MMA(0, 0, At, B0); PG8_BAR; PG8_SCHED;
            PG8_LDB(B1, 1, 1); PG8_STAGE(PG8_SB(1, 0), b3, voffB);
            PG8_BAR; PG8_WAIT_L(0); PG8_MMA(0, 1, At, B1); PG8_BAR;
            PG8_LDA(At, 1, 1); PG8_STAGE(PG8_SA(1, 0), a3, voffA);
            PG8_BAR; PG8_WAIT_L(0); PG8_MMA(1, 0, At, B0); PG8_BAR; PG8_SCHED;
            PG8_STAGE(PG8_SB(1, 1), b3 + hstep, voffB);
            PG8_WAIT_V(6); PG8_BAR; PG8_MMA(1, 1, At, B1); PG8_BAR;
            }
        }
        if constexpr (ALIGN_EPI) { if (wr == 0) PG8_BAR; }
        if constexpr (!Epi::AFTER_DRAIN) { E(acc, cur, wr, wc, fr, fq); S.done(cur); }
        if (!has_next) break;
#pragma unroll
        for (int a = 0; a < 2; ++a)
#pragma unroll
            for (int b = 0; b < 2; ++b)
#pragma unroll
                for (int m = 0; m < 4; ++m)
#pragma unroll
                    for (int n = 0; n < 2; ++n) acc[a][b][m][n] = (f32x4){0.f, 0.f, 0.f, 0.f};
        cur = nxt; cA = nA; cB = nB; ++ui;
        if constexpr (ALIGN_EPI) { if (wr == 1) PG8_BAR; }
    }
    PG8_WAIT_V(0);
    if constexpr (!ALIGN_EPI) { if (wr == 0) PG8_BAR; }
    PG8_BAR;
    if constexpr (Epi::AFTER_DRAIN) { E.fused(acc, cur, wr, wc, fr, fq, lds, wid, lane); S.done(cur); }
#undef PG8_SA
#undef PG8_SB
#undef PG8_STAGE
#undef PG8_LDA
#undef PG8_LDB
#undef PG8_MMA
#undef PG8_WAIT_V
#undef PG8_WAIT_L
#undef PG8_BAR
#undef PG8_SCHED
}
}
constexpr int NWAVES = 8;
constexpr int BATCH = 8, T = 4096, D = 1024, M = BATCH * T, FF = 4096, NPROJ = 3840, NMOD = 6 * D, INW = 3600;
constexpr float EPS = 1e-6f;
constexpr size_t MiB = 1u << 20;
constexpr size_t WS_CTL = 0, CTL_ZERO_BYTES = 64 * 1024;
constexpr size_t WS_MOD = 1 * MiB, WS_LB = 1 * MiB + 256 * 1024;
constexpr size_t WS_WIN = 2 * MiB, WS_WOUT = 10 * MiB, WS_W1 = 12 * MiB, WS_W2 = 20 * MiB;
constexpr size_t WS_ACT = 32 * MiB;
constexpr size_t WS_PROJ = 96 * MiB;
constexpr size_t WS_END = 352 * MiB;
constexpr int CW_BAR = 1024;
constexpr int RING_BYTES = 131072, LDSCTL_OFF = RING_BYTES, MISC_OFF = LDSCTL_OFF + 320, LDS_BYTES = 147456;
constexpr int N_PHASES = 9;

#define GAS __attribute__((address_space(1)))
#define LAS __attribute__((address_space(3)))
typedef unsigned short bf16;
typedef unsigned v4u __attribute__((ext_vector_type(4)));
typedef unsigned v2u __attribute__((ext_vector_type(2)));
typedef float f32x4 __attribute__((ext_vector_type(4)));
typedef float f32x2 __attribute__((ext_vector_type(2)));
typedef short bf16x8 __attribute__((ext_vector_type(8)));
typedef GAS unsigned gu32;
#define RLX_AGENT __ATOMIC_RELAXED, __HIP_MEMORY_SCOPE_AGENT
#define LDS_WAIT() asm volatile("s_waitcnt lgkmcnt(0)" ::: "memory")
#define VM_WAIT() asm volatile("s_waitcnt vmcnt(0)" ::: "memory")
__device__ __forceinline__ unsigned pk2(float lo, float hi) { return pg8::cvt_pk_bf16(lo, hi); }
__device__ __forceinline__ float bf_lo(unsigned u) { return __uint_as_float(u << 16); }
__device__ __forceinline__ float bf_hi(unsigned u) { return __uint_as_float(u & 0xffff0000u); }
#define XB_TMO      128
#define XB_XCNT(j)  (256  + 64 * (j))
#define XB_XSUB(j)  (1280 + 64 * (j))
#define XB_XGEN(j)  (2304 + 64 * (j))
#define XB_TOP      3328
#define XB_TOPGEN   3392
#define XCD_BAR_WORDS 3456
#define XB_SPIN_CAP (1u << 18)

__device__ __forceinline__ unsigned xb_ld(unsigned* p)              { return __hip_atomic_load(p, __ATOMIC_RELAXED, __HIP_MEMORY_SCOPE_AGENT); }
__device__ __forceinline__ unsigned xb_add(unsigned* p, unsigned v) { return __hip_atomic_fetch_add(p, v, __ATOMIC_RELAXED, __HIP_MEMORY_SCOPE_AGENT); }
__device__ __forceinline__ unsigned xb_xcc_id() { return (unsigned)__builtin_amdgcn_s_getreg((3 << 11) | 20) & 0xFu; }
#define XB_SPIN(cond, bar) do { unsigned _sp = 0; while (cond) { __builtin_amdgcn_s_sleep(1); \
    if ((++_sp & 255u) == 0u) { if (xb_ld(&(bar)[XB_TMO])) break; if (_sp > XB_SPIN_CAP) { atomicAdd(&(bar)[XB_TMO], 1u); break; } } } } while (0)

struct XcdBarrier {
    unsigned* bar; unsigned x;
    volatile LAS unsigned* st;
};

__device__ __forceinline__ XcdBarrier xcd_barrier_post(unsigned* bar, volatile LAS unsigned* st) {
    XcdBarrier b; b.bar = bar; b.x = xb_xcc_id(); b.st = st;
    if (threadIdx.x == 0) (void)xb_add(&bar[XB_XCNT(b.x)], 1u);
    return b;
}
__device__ __forceinline__ void xcd_barrier_complete(unsigned* bar, unsigned x, unsigned& nloc, unsigned& nx) {
    const unsigned G = gridDim.x * gridDim.y * gridDim.z;
    unsigned sum, cnt, mine, sp = 0u;
    for (;;) {
        sum = 0u; cnt = 0u; mine = 0u;
#pragma unroll
        for (unsigned j = 0; j < 16; ++j) { const unsigned c = xb_ld(&bar[XB_XCNT(j)]); sum += c; cnt += (c > 0u) ? 1u : 0u; mine = (j == x) ? c : mine; }
        if (sum == G) break;
        __builtin_amdgcn_s_sleep(1);
        if ((++sp & 255u) == 0u) { if (xb_ld(&bar[XB_TMO])) break; if (sp > XB_SPIN_CAP) { atomicAdd(&bar[XB_TMO], 1u); break; } }
    }
    nloc = mine > 0u ? mine : 1u; nx = cnt > 0u ? cnt : 1u;
}

__device__ __forceinline__ void xcd_barrier(const XcdBarrier& b) {
    asm volatile("s_waitcnt vmcnt(0)" ::: "memory");
    __syncthreads();
    if (threadIdx.x == 0) {
        unsigned* bar = b.bar;
        __builtin_amdgcn_s_waitcnt(0);
        unsigned nloc = b.st[0], nx = b.st[1];
        if (nloc == 0u) { xcd_barrier_complete(bar, b.x, nloc, nx); b.st[0] = nloc; b.st[1] = nx; }
        const unsigned old = xb_add(&bar[XB_XSUB(b.x)], 1u);
        const unsigned gen = old / nloc;
        if (old + 1u == (gen + 1u) * nloc) {
            __builtin_amdgcn_fence(__ATOMIC_RELEASE, "agent");
            asm volatile("s_waitcnt vmcnt(0)" ::: "memory");
            const unsigned og = xb_add(&bar[XB_TOP], 1u);
            const unsigned tg = og / nx;
            if (og + 1u == (tg + 1u) * nx) xb_add(&bar[XB_TOPGEN], 1u);
            else XB_SPIN(xb_ld(&bar[XB_TOPGEN]) == tg, bar);
            __builtin_amdgcn_fence(__ATOMIC_ACQUIRE, "agent");
            xb_add(&bar[XB_XGEN(b.x)], 1u);
            asm volatile("s_waitcnt vmcnt(0)" ::: "memory");
        } else {
            XB_SPIN(xb_ld(&bar[XB_XGEN(b.x)]) == gen, bar);
            __builtin_amdgcn_fence(__ATOMIC_ACQUIRE, "agent");
            asm volatile("s_waitcnt vmcnt(0)" ::: "memory");
        }
    }
    __syncthreads();
}
struct Frame {
    LAS unsigned char* lds;
    int tid, lane, wave, vcu, G;
};
__device__ __forceinline__ float wave_sum(float v) {
#pragma unroll
    for (int o = 1; o < 64; o <<= 1) v += __shfl_xor(v, o);
    return v;
}
__device__ __forceinline__ void transpose_item(const float* W, int ldw, int c0, int K, bf16* WT, int r0, LAS float* scr, int kb, int nb, int lane) {
    const int k0 = 64 * kb, n0 = 32 * nb;
#pragma unroll 8
    for (int i = 0; i < 32; ++i) { const int kk = 2 * i + (lane >> 5); scr[kk * 33 + (lane & 31)] = W[(size_t)(k0 + kk) * ldw + c0 + n0 + (lane & 31)]; }
    LDS_WAIT(); asm volatile("" ::: "memory");
    const int c = lane & 7;
#pragma unroll
    for (int j = 0; j < 4; ++j) { const int n = (lane >> 3) + 8 * j; const LAS float* s = scr + (8 * c) * 33 + n;
        v4u o; o.x = pk2(s[0 * 33], s[1 * 33]); o.y = pk2(s[2 * 33], s[3 * 33]); o.z = pk2(s[4 * 33], s[5 * 33]); o.w = pk2(s[6 * 33], s[7 * 33]);
        *(GAS v4u*)(WT + (size_t)(r0 + n0 + n) * K + k0 + 8 * c) = o; }
    LDS_WAIT(); asm volatile("" ::: "memory");
}
struct Ptrs {
    const float *x, *c, *w_ada, *b_ada, *w_in, *w2g, *b2g, *gla_g, *lb_logits, *hgrn_g, *w_out, *w1, *w2, *fin_g;
    float* out; unsigned char* ws;
};
__device__ __forceinline__ void p0_prologue(const Frame& F, const Ptrs& P) {
    float* MOD = (float*)(P.ws + WS_MOD); float* LB = (float*)(P.ws + WS_LB);
    bf16* WIN = (bf16*)(P.ws + WS_WIN); bf16* WOUT = (bf16*)(P.ws + WS_WOUT); bf16* W1T = (bf16*)(P.ws + WS_W1); bf16* W2T = (bf16*)(P.ws + WS_W2);
    if (blockIdx.x < (unsigned)(NMOD / 64)) {
        LAS float* sc = (LAS float*)F.lds;
        LAS float* red = (LAS float*)(F.lds + 32768);
        for (int i = F.tid; i < BATCH * D; i += 512) { const float v = P.c[i]; sc[i] = v * pg8::fsigmoid(v); }
        __syncthreads();
        for (int jg = blockIdx.x; jg < NMOD / 64; jg += F.G) {
            const int j = jg * 64 + F.lane; float a[BATCH];
#pragma unroll
            for (int b = 0; b < BATCH; ++b) a[b] = 0.f;
            const int kbeg = F.wave * 128;
#pragma unroll 8
            for (int k = kbeg; k < kbeg + 128; ++k) { const float wv = P.w_ada[(size_t)k * NMOD + j];
#pragma unroll
                for (int b = 0; b < BATCH; ++b) a[b] += sc[b * D + k] * wv; }
#pragma unroll
            for (int b = 0; b < BATCH; ++b) red[(F.wave * BATCH + b) * 64 + F.lane] = a[b];
            __syncthreads();
            { const int b = F.tid >> 6; float s = P.b_ada[j];
#pragma unroll
              for (int w = 0; w < 8; ++w) s += red[(w * BATCH + b) * 64 + F.lane];
              MOD[b * NMOD + j] = s; }
            __syncthreads();
        }
    }
    if (blockIdx.x == (unsigned)(F.G - 1)) { for (int i = F.tid; i < 512; i += 512) { const float l0 = P.lb_logits[i], l1 = P.lb_logits[512 + i]; const float mx = fmaxf(l0, l1); const float e0 = __expf(l0 - mx), e1 = __expf(l1 - mx); LB[i] = e0 / (e0 + e1); } }
    __syncthreads();
    LAS float* scr = (LAS float*)(F.lds + F.wave * 16384);
    const int gw = F.vcu * NWAVES + F.wave, NGW = F.G * NWAVES;
    constexpr int KB1 = D / 64;
    constexpr int I_A = KB1 * (512 / 32), I_B = KB1 * (512 / 32), I_C = KB1 * (2560 / 32), I_O = KB1 * (D / 32), I_1 = KB1 * (FF / 32), I_2 = (FF / 64) * (D / 32);
    constexpr int I_G = 256 * 128 / 64;
    constexpr int NITEMS = I_A + I_B + I_C + I_O + I_1 + I_2 + I_G;
    for (int it = gw; it < NITEMS; it += NGW) {
        int r = it;
        if (r < I_A) { transpose_item(P.w_in, INW, 0, D, WIN, 0, scr, r / 16, r % 16, F.lane); continue; } r -= I_A;
        if (r < I_B) { transpose_item(P.w_in, INW, 512, D, WIN, 768, scr, r / 16, r % 16, F.lane); continue; } r -= I_B;
        if (r < I_C) { transpose_item(P.w_in, INW, 1040, D, WIN, 1280, scr, r / 80, r % 80, F.lane); continue; } r -= I_C;
        if (r < I_O) { transpose_item(P.w_out, D, 0, D, WOUT, 0, scr, r / 32, r % 32, F.lane); continue; } r -= I_O;
        if (r < I_1) { transpose_item(P.w1, FF, 0, D, W1T, 0, scr, r / 128, r % 128, F.lane); continue; } r -= I_1;
        if (r < I_2) { transpose_item(P.w2, D, 0, FF, W2T, 0, scr, r / 32, r % 32, F.lane); continue; } r -= I_2;
        {
            const int idx = r * 64 + F.lane, n = idx >> 7, ko = idx & 127;
            float wr[16];
#pragma unroll
            for (int q = 0; q < 16; ++q) wr[q] = P.w2g[q * 256 + n];
            float o[8];
#pragma unroll
            for (int kk = 0; kk < 8; ++kk) { const float* src = P.w_in + (size_t)(ko * 8 + kk) * INW + 1024; float s = 0.f;
#pragma unroll
                for (int q4 = 0; q4 < 4; ++q4) { const f32x4 v = *(const f32x4*)(src + 4 * q4); s += v[0] * wr[4 * q4] + v[1] * wr[4 * q4 + 1] + v[2] * wr[4 * q4 + 2] + v[3] * wr[4 * q4 + 3]; }
                o[kk] = s; }
            v4u w; w.x = pk2(o[0], o[1]); w.y = pk2(o[2], o[3]); w.z = pk2(o[4], o[5]); w.w = pk2(o[6], o[7]);
            *(GAS v4u*)(WIN + (size_t)(512 + n) * D + ko * 8) = w;
        }
    }
}
__device__ __forceinline__ void rows_modulate(const Frame& F, const float* src, bf16* dst, const float* shift, const float* scale) {
    const int gw = F.vcu * NWAVES + F.wave, NGW = F.G * NWAVES;
    for (int m = gw; m < M; m += NGW) {
        const GAS f32x4* xr = (const GAS f32x4*)(src + (size_t)m * D) + F.lane;
        const int b = m / T;
        f32x4 v[4]; float s = 0.f;
#pragma unroll
        for (int j = 0; j < 4; ++j) { v[j] = xr[64 * j]; s += (v[j].x * v[j].x + v[j].y * v[j].y) + (v[j].z * v[j].z + v[j].w * v[j].w); }
        const float rstd = rsqrtf(wave_sum(s) * (1.f / D) + EPS);
        GAS v2u* o8 = (GAS v2u*)(dst + (size_t)m * D) + F.lane;
#pragma unroll
        for (int j = 0; j < 4; ++j) { const f32x4 sc = *((const f32x4*)(scale + (size_t)b * NMOD) + F.lane + 64 * j), sh = *((const f32x4*)(shift + (size_t)b * NMOD) + F.lane + 64 * j);
            const f32x4 h = v[j] * rstd * (sc + 1.0f) + sh; v2u w; w.x = pk2(h.x, h.y); w.y = pk2(h.z, h.w); o8[64 * j] = w; }
    }
}
__device__ __forceinline__ void rows_final(const Frame& F, float* buf, const float* g) {
    const int gw = F.vcu * NWAVES + F.wave, NGW = F.G * NWAVES;
    f32x4 gv[4];
#pragma unroll
    for (int j = 0; j < 4; ++j) gv[j] = *((const f32x4*)g + F.lane + 64 * j);
    for (int m = gw; m < M; m += NGW) {
        GAS f32x4* xr = (GAS f32x4*)(buf + (size_t)m * D) + F.lane;
        f32x4 v[4]; float s = 0.f;
#pragma unroll
        for (int j = 0; j < 4; ++j) { v[j] = xr[64 * j]; s += (v[j].x * v[j].x + v[j].y * v[j].y) + (v[j].z * v[j].z + v[j].w * v[j].w); }
        const float rstd = rsqrtf(wave_sum(s) * (1.f / D) + EPS);
#pragma unroll
        for (int j = 0; j < 4; ++j) xr[64 * j] = v[j] * rstd * gv[j];
    }
}
__device__ __forceinline__ f32x4 mfma_safe(bf16x8 a, bf16x8 b, f32x4 c) { f32x4 d = __builtin_amdgcn_mfma_f32_16x16x32_bf16(a, b, c, 0, 0, 0); asm volatile("" :: "v"(a), "v"(b)); return d; }
template <int DK, bool HGRN>
__device__ __forceinline__ void scan_item(LAS unsigned char* lds, const bf16* PROJ, bf16* OMIX, const float* gain, int b, int qc, int kc, int lac, int vc, int gc, int oc, int tid) {
    constexpr int DKP = DK + 8, NP = DK / 2, NSEG = 512 / NP, TL = 64 / NSEG, NDB = DK / 16, NKS = DK / 32;
    constexpr int OFF_QR = 0, OFF_KR = OFF_QR + 64 * DKP * 2, OFF_KRT = OFF_KR + 64 * DKP * 2, OFF_VT = OFF_KRT + DK * 144, OFF_P = OFF_VT + 128 * 144, OFF_ST = OFF_P + 64 * 144,
                  OFF_SEG = OFF_ST + 128 * DKP * 2, OFF_VEC = OFF_SEG + NSEG * DK * 4, OFF_RMS = OFF_VEC + 3 * DK * 4, OFF_END = OFF_RMS + 2 * 64 * 4;
    static_assert(OFF_END <= RING_BYTES, "scan LDS");
    constexpr float LOG2E = 1.4426950408889634f;
    const int lane = tid & 63, w = __builtin_amdgcn_readfirstlane(tid >> 6), l15 = lane & 15, lq = lane >> 4;
    const int p = tid % NP, seg = tid / NP, t0 = seg * TL;
    const int ep = tid & 63, sseg = tid >> 6;
    const int tb = w & 3, eh = w >> 2;
    f32x4 S[NDB];
#pragma unroll
    for (int i = 0; i < NDB; ++i) S[i] = (f32x4){0.f, 0.f, 0.f, 0.f};
    f32x4 gn[4];
#pragma unroll
    for (int j = 0; j < 4; ++j) gn[j] = *(const f32x4*)(gain + (eh * 4 + j) * 16 + 4 * lq);

    for (int c = 0; c < T / 64; ++c) {
        const size_t row0 = (size_t)b * T + (size_t)c * 64;
        const char* cb = (const char*)PROJ + row0 * (size_t)(NPROJ * 2);
        const unsigned toff = (unsigned)(t0 * NPROJ + 2 * p) * 2u, voff = (unsigned)(8 * sseg * NPROJ + vc + 2 * ep) * 2u, goff = (unsigned)((tb * 16 + l15) * NPROJ + gc + eh * 64 + 4 * lq) * 2u;
        unsigned ula[TL], uq[TL], uk[TL];
#pragma unroll
        for (int i = 0; i < TL; ++i) { ula[i] = *(const unsigned*)(cb + (size_t)(i * NPROJ + lac) * 2 + toff); uq[i] = *(const unsigned*)(cb + (size_t)(i * NPROJ + qc) * 2 + toff);
            if (!HGRN) uk[i] = *(const unsigned*)(cb + (size_t)(i * NPROJ + kc) * 2 + toff); else uk[i] = 0u; }
        unsigned uv[8];
#pragma unroll
        for (int i = 0; i < 8; ++i) uv[i] = *(const unsigned*)(cb + (size_t)(i * NPROJ) * 2 + voff);
        v2u ugate[4];
#pragma unroll
        for (int j = 0; j < 4; ++j) ugate[j] = *(const v2u*)(cb + (size_t)(j * 32) + goff);
        f32x2 cl[TL]; f32x2 run = (f32x2){0.f, 0.f};
#pragma unroll
        for (int i = 0; i < TL; ++i) { run.x += bf_lo(ula[i]) * LOG2E; run.y += bf_hi(ula[i]) * LOG2E; cl[i] = run; }
        *(LAS f32x2*)(lds + OFF_SEG + (seg * DK + 2 * p) * 4) = run;
        { v4u a, bq; a.x = (uv[0] & 0xffffu) | (uv[1] << 16); a.y = (uv[2] & 0xffffu) | (uv[3] << 16); a.z = (uv[4] & 0xffffu) | (uv[5] << 16); a.w = (uv[6] & 0xffffu) | (uv[7] << 16);
          bq.x = (uv[0] >> 16) | (uv[1] & 0xffff0000u); bq.y = (uv[2] >> 16) | (uv[3] & 0xffff0000u); bq.z = (uv[4] >> 16) | (uv[5] & 0xffff0000u); bq.w = (uv[6] >> 16) | (uv[7] & 0xffff0000u);
          *(LAS v4u*)(lds + OFF_VT + (2 * ep) * 144 + sseg * 16) = a; *(LAS v4u*)(lds + OFF_VT + (2 * ep + 1) * 144 + sseg * 16) = bq; }
        __syncthreads();
        f32x2 pre = (f32x2){0.f, 0.f}, mid = (f32x2){0.f, 0.f}, last = (f32x2){0.f, 0.f};
#pragma unroll
        for (int j = 0; j < NSEG; ++j) { const f32x2 tj = *(const LAS f32x2*)(lds + OFF_SEG + (j * DK + 2 * p) * 4);
            if (j < seg) pre += tj; if (j < NSEG / 2) mid += tj; last += tj; }
        if (seg == 0) { LAS float* vec = (LAS float*)(lds + OFF_VEC);
            *(LAS f32x2*)(vec + 2 * p) = (f32x2){__builtin_amdgcn_exp2f(mid.x), __builtin_amdgcn_exp2f(mid.y)};
            *(LAS f32x2*)(vec + DK + 2 * p) = (f32x2){__builtin_amdgcn_exp2f(last.x - mid.x), __builtin_amdgcn_exp2f(last.y - mid.y)};
            *(LAS f32x2*)(vec + 2 * DK + 2 * p) = (f32x2){__builtin_amdgcn_exp2f(last.x), __builtin_amdgcn_exp2f(last.y)}; }
        unsigned kt0[TL / 2], kt1[TL / 2];
#pragma unroll
        for (int i = 0; i < TL; i += 2) {
            float krx[2], kry[2];
#pragma unroll
            for (int ii = 0; ii < 2; ++ii) { const int i2 = i + ii;
                const float cx = pre.x + cl[i2].x, cy = pre.y + cl[i2].y;
                const float ax = __builtin_amdgcn_exp2f(cx - mid.x), ay = __builtin_amdgcn_exp2f(cy - mid.y);
                const float bx = __builtin_amdgcn_exp2f(mid.x - cx), by = __builtin_amdgcn_exp2f(mid.y - cy);
                float kx, ky;
                if (HGRN) { kx = 1.0f - __builtin_amdgcn_exp2f(bf_lo(ula[i2]) * LOG2E); ky = 1.0f - __builtin_amdgcn_exp2f(bf_hi(ula[i2]) * LOG2E); }
                else { kx = bf_lo(uk[i2]); ky = bf_hi(uk[i2]); }
                const float qx = bf_lo(uq[i2]) * ax, qy = bf_hi(uq[i2]) * ay;
                krx[ii] = kx * bx; kry[ii] = ky * by;
                *(LAS unsigned*)(lds + OFF_QR + (t0 + i2) * (DKP * 2) + 4 * p) = pk2(qx, qy);
                *(LAS unsigned*)(lds + OFF_KR + (t0 + i2) * (DKP * 2) + 4 * p) = pk2(krx[ii], kry[ii]); }
            kt0[i / 2] = pk2(krx[0], krx[1]); kt1[i / 2] = pk2(kry[0], kry[1]);
        }
        if (TL == 8) { *(LAS v4u*)(lds + OFF_KRT + (2 * p) * 144 + t0 * 2) = (v4u){kt0[0], kt0[1], kt0[2 % (TL / 2)], kt0[3 % (TL / 2)]};
                       *(LAS v4u*)(lds + OFF_KRT + (2 * p + 1) * 144 + t0 * 2) = (v4u){kt1[0], kt1[1], kt1[2 % (TL / 2)], kt1[3 % (TL / 2)]}; }
        else { *(LAS v2u*)(lds + OFF_KRT + (2 * p) * 144 + t0 * 2) = (v2u){kt0[0], kt0[1]}; *(LAS v2u*)(lds + OFF_KRT + (2 * p + 1) * 144 + t0 * 2) = (v2u){kt1[0], kt1[1]}; }
        __syncthreads();
#pragma unroll
        for (int db = 0; db < NDB; ++db) { const f32x4 em = *(const LAS f32x4*)(lds + OFF_VEC + (db * 16 + 4 * lq) * 4); const f32x4 v = S[db] * em;
            *(LAS v2u*)(lds + OFF_ST + (w * 16 + l15) * (DKP * 2) + (db * 16 + 4 * lq) * 2) = (v2u){pk2(v[0], v[1]), pk2(v[2], v[3])}; }
#pragma unroll
        for (int h2 = 0; h2 < 2; ++h2) { const int id = w + 8 * h2, ti = id >> 2, si = id & 3;
            f32x4 acc = (f32x4){0.f, 0.f, 0.f, 0.f};
            if (si <= ti) {
#pragma unroll
                for (int ks = 0; ks < NKS; ++ks) { const bf16x8 a = *(const LAS bf16x8*)(lds + OFF_KR + (si * 16 + l15) * (DKP * 2) + (ks * 32 + 8 * lq) * 2);
                    const bf16x8 bb = *(const LAS bf16x8*)(lds + OFF_QR + (ti * 16 + l15) * (DKP * 2) + (ks * 32 + 8 * lq) * 2);
                    acc = __builtin_amdgcn_mfma_f32_16x16x32_bf16(a, bb, acc, 0, 0, 0); }
                if (si == ti) {
#pragma unroll
                    for (int r = 0; r < 4; ++r) if (4 * lq + r > l15) acc[r] = 0.f; }
            }
            *(LAS v2u*)(lds + OFF_P + (ti * 16 + l15) * 144 + (si * 16 + 4 * lq) * 2) = (v2u){pk2(acc[0], acc[1]), pk2(acc[2], acc[3])};
        }
        __syncthreads();
        f32x4 o[4];
        { bf16x8 pB[2], qB[NKS];
#pragma unroll
          for (int ks = 0; ks < 2; ++ks) pB[ks] = *(const LAS bf16x8*)(lds + OFF_P + (tb * 16 + l15) * 144 + (ks * 32 + 8 * lq) * 2);
#pragma unroll
          for (int ks = 0; ks < NKS; ++ks) qB[ks] = *(const LAS bf16x8*)(lds + OFF_QR + (tb * 16 + l15) * (DKP * 2) + (ks * 32 + 8 * lq) * 2);
#pragma unroll
          for (int j = 0; j < 4; ++j) { const int eb = eh * 4 + j; f32x4 acc = (f32x4){0.f, 0.f, 0.f, 0.f};
#pragma unroll
              for (int ks = 0; ks < 2; ++ks) { const bf16x8 a = *(const LAS bf16x8*)(lds + OFF_VT + (eb * 16 + l15) * 144 + (ks * 32 + 8 * lq) * 2); acc = __builtin_amdgcn_mfma_f32_16x16x32_bf16(a, pB[ks], acc, 0, 0, 0); }
#pragma unroll
              for (int ks = 0; ks < NKS; ++ks) { const bf16x8 a = *(const LAS bf16x8*)(lds + OFF_ST + (eb * 16 + l15) * (DKP * 2) + (ks * 32 + 8 * lq) * 2); acc = __builtin_amdgcn_mfma_f32_16x16x32_bf16(a, qB[ks], acc, 0, 0, 0); }
              o[j] = acc; } }
        { bf16x8 vB[2];
#pragma unroll
          for (int ks = 0; ks < 2; ++ks) vB[ks] = *(const LAS bf16x8*)(lds + OFF_VT + (w * 16 + l15) * 144 + (ks * 32 + 8 * lq) * 2);
#pragma unroll
          for (int db = 0; db < NDB; ++db) { f32x4 acc = (f32x4){0.f, 0.f, 0.f, 0.f};
#pragma unroll
              for (int ks = 0; ks < 2; ++ks) { const bf16x8 a = *(const LAS bf16x8*)(lds + OFF_KRT + (db * 16 + l15) * 144 + (ks * 32 + 8 * lq) * 2); acc = __builtin_amdgcn_mfma_f32_16x16x32_bf16(a, vB[ks], acc, 0, 0, 0); }
              const f32x4 gg = *(const LAS f32x4*)(lds + OFF_VEC + (DK + db * 16 + 4 * lq) * 4), dec = *(const LAS f32x4*)(lds + OFF_VEC + (2 * DK + db * 16 + 4 * lq) * 4);
              S[db] = dec * S[db] + gg * acc; } }
        float ss = 0.f;
#pragma unroll
        for (int j = 0; j < 4; ++j) ss += (o[j][0] * o[j][0] + o[j][1] * o[j][1]) + (o[j][2] * o[j][2] + o[j][3] * o[j][3]);
        ss += __shfl_xor(ss, 16); ss += __shfl_xor(ss, 32);
        if (lane < 16) *(LAS float*)(lds + OFF_RMS + (eh * 64 + tb * 16 + lane) * 4) = ss;
        __syncthreads();
        const float tot = *(const LAS float*)(lds + OFF_RMS + (tb * 16 + l15) * 4) + *(const LAS float*)(lds + OFF_RMS + (64 + tb * 16 + l15) * 4);
        const float rstd = rsqrtf(tot * (1.0f / 128.0f) + EPS);
        char* ob = (char*)OMIX + row0 * (size_t)(D * 2); const unsigned ooff = (unsigned)((tb * 16 + l15) * D + oc + eh * 64 + 4 * lq) * 2u;
#pragma unroll
        for (int j = 0; j < 4; ++j) { const f32x4 v = o[j] * rstd * gn[j];
            *(v2u*)(ob + (size_t)(j * 32) + ooff) = (v2u){pk2(v[0] * bf_lo(ugate[j].x), v[1] * bf_hi(ugate[j].x)), pk2(v[2] * bf_lo(ugate[j].y), v[3] * bf_hi(ugate[j].y))}; }
    }
}
struct Args { const float* in[14]; float* out; unsigned char* ws; int ph_lo, ph_hi; };
__global__ void __launch_bounds__(NWAVES * 64, 2) hymba_fwd(Args args) {
    extern __shared__ __attribute__((aligned(16))) unsigned char lds_raw[];
    Frame F;
    F.lds = (LAS unsigned char*)lds_raw;
    volatile LAS unsigned* MISC = (volatile LAS unsigned*)(F.lds + MISC_OFF);
    F.tid = threadIdx.x; F.lane = F.tid & 63; F.wave = __builtin_amdgcn_readfirstlane(F.tid >> 6);
    F.G = gridDim.x; { const int bx = blockIdx.x; F.vcu = (F.G % 8 == 0) ? (bx % 8) * (F.G / 8) + bx / 8 : bx; }
    Ptrs P;
    P.x = args.in[0]; P.c = args.in[1]; P.w_ada = args.in[2]; P.b_ada = args.in[3]; P.w_in = args.in[4]; P.w2g = args.in[5]; P.b2g = args.in[6]; P.gla_g = args.in[7];
    P.lb_logits = args.in[8]; P.hgrn_g = args.in[9]; P.w_out = args.in[10]; P.w1 = args.in[11]; P.w2 = args.in[12]; P.fin_g = args.in[13]; P.out = args.out; P.ws = args.ws;
    unsigned char* ws = args.ws;
    const float* MOD = (const float*)(ws + WS_MOD); const float* LB = (const float*)(ws + WS_LB);
    bf16* WIN = (bf16*)(ws + WS_WIN); bf16* WOUT = (bf16*)(ws + WS_WOUT); bf16* W1T = (bf16*)(ws + WS_W1); bf16* W2T = (bf16*)(ws + WS_W2);
    bf16* ACT = (bf16*)(ws + WS_ACT); bf16* PROJ = (bf16*)(ws + WS_PROJ); bf16* HB = (bf16*)(ws + WS_PROJ);
    for (int u = F.tid; u < (LDS_BYTES - LDSCTL_OFF) / 4; u += NWAVES * 64) ((LAS unsigned*)(F.lds + LDSCTL_OFF))[u] = 0u;
    __syncthreads();
    const int lo = args.ph_lo, hi = args.ph_hi;
    const bool single = (hi - lo) > 1;
    XcdBarrier bar; bar.bar = (unsigned*)(ws + WS_CTL) + CW_BAR; bar.x = 0; bar.st = nullptr;
    if (single) bar = xcd_barrier_post((unsigned*)(ws + WS_CTL) + CW_BAR, MISC + 8);
#define IN(k) (lo <= (k) && (k) < hi)
#define SEAM(k) do { if (IN(k) && IN((k) + 1)) xcd_barrier(bar); } while (0)

    if (IN(0)) { p0_prologue(F, P); } SEAM(0);
    if (IN(1)) { rows_modulate(F, P.x, ACT, MOD + 0 * D, MOD + 1 * D); } SEAM(1);
    if (IN(2)) {
        pg8::Gemm g{ACT, WIN, M, NPROJ, D}; pg8::StaticOrder S; S.init(M, NPROJ, F.G, (int)blockIdx.x);
        pg8::EpiProj E{PROJ, NPROJ, P.b2g, LB};
        pg8::gemm_phase<pg8::EpiProj, pg8::StaticOrder, true, true>(F.lds, g, S, E);
    } SEAM(2);
    if (IN(3)) {
        for (int item = blockIdx.x; item < 64; item += F.G) {
            const int b = item >> 3, h8 = item & 7;
            if (h8 < 4) { const int h = h8; scan_item<64, false>(F.lds, PROJ, ACT, P.gla_g, b, h * 64, 256 + h * 64, 512 + h * 64, 768 + h * 128, 1280 + h * 128, h * 128, F.tid); }
            else { const int h = h8 - 4; scan_item<128, true>(F.lds, PROJ, ACT, P.hgrn_g, b, 1792 + h * 128, 0, 2304 + h * 128, 2816 + h * 128, 3328 + h * 128, 512 + h * 128, F.tid); }
            __syncthreads();
        }
    } SEAM(3);
    if (IN(4)) {
        pg8::Gemm g{ACT, WOUT, M, D, D}; pg8::StaticOrder S; S.init(M, D, F.G, (int)blockIdx.x);
        pg8::EpiRes E{P.x, P.out, D, MOD + 2 * D, NMOD, T};
        pg8::gemm_phase<pg8::EpiRes, pg8::StaticOrder, true, true>(F.lds, g, S, E);
    } SEAM(4);
    if (IN(5)) { rows_modulate(F, P.out, ACT, MOD + 3 * D, MOD + 4 * D); } SEAM(5);
    if (IN(6)) {
        pg8::Gemm g{ACT, W1T, M, FF, D}; pg8::StaticOrder S; S.init(M, FF, F.G, (int)blockIdx.x);
        pg8::EpiRelu2 E{HB, FF};
        pg8::gemm_phase<pg8::EpiRelu2, pg8::StaticOrder, true, true>(F.lds, g, S, E);
    } SEAM(6);
    if (IN(7)) {
        pg8::Gemm g{HB, W2T, M, D, FF}; pg8::StaticOrder S; S.init(M, D, F.G, (int)blockIdx.x);
        pg8::EpiRes E{P.out, P.out, D, MOD + 5 * D, NMOD, T};
        pg8::gemm_phase<pg8::EpiRes, pg8::StaticOrder, true, true>(F.lds, g, S, E);
    } SEAM(7);
    if (IN(8)) { rows_final(F, P.out, P.fin_g); }
#undef IN
#undef SEAM
}

#ifndef MK_N_LAUNCHES
#define MK_N_LAUNCHES 1
#endif
extern "C" void kernel_launch(void* const* d_in, const int* in_sizes, int n_in, void* d_out, int out_size, void* d_ws, size_t ws_size, hipStream_t stream) {
    static int grid = 0;
    if (grid == 0) {
        if (n_in != 14 || out_size != M * D || ws_size < WS_END) { fprintf(stderr, "kernel_launch: unexpected shapes (n_in %d, out %d, ws %zu)\n", n_in, out_size, ws_size); grid = -1; return; }
        int dev = 0, cus = 0, per_cu = 0;
        if (hipGetDevice(&dev) != hipSuccess || hipDeviceGetAttribute(&cus, hipDeviceAttributeMultiprocessorCount, dev) != hipSuccess) { grid = -1; return; }
        if (hipFuncSetAttribute((const void*)hymba_fwd, hipFuncAttributeMaxDynamicSharedMemorySize, LDS_BYTES) != hipSuccess) { fprintf(stderr, "kernel_launch: hipFuncSetAttribute failed\n"); grid = -1; return; }
        if (hipOccupancyMaxActiveBlocksPerMultiprocessor(&per_cu, (const void*)hymba_fwd, NWAVES * 64, LDS_BYTES) != hipSuccess || per_cu < 1) { fprintf(stderr, "kernel_launch: occupancy query says %d\n", per_cu); per_cu = 1; }
        (void)hipGetLastError();
        grid = cus;
    }
    if (grid < 0) return;
    (void)hipMemsetAsync((char*)d_ws + WS_CTL, 0, CTL_ZERO_BYTES, stream);
    Args a{};
    for (int i = 0; i < 14; ++i) a.in[i] = (const float*)d_in[i];
    a.out = (float*)d_out; a.ws = (unsigned char*)d_ws;
#if MK_N_LAUNCHES == 1
    a.ph_lo = 0; a.ph_hi = N_PHASES;
    void* kargs[] = {&a};
    hipError_t e = hipLaunchCooperativeKernel((const void*)hymba_fwd, dim3(grid), dim3(NWAVES * 64), kargs, LDS_BYTES, stream);
    if (e != hipSuccess) fprintf(stderr, "kernel_launch: cooperative launch failed: %s (grid %d)\n", hipGetErrorString(e), grid);
#else
    for (int li = 0; li < N_PHASES; ++li) { a.ph_lo = li; a.ph_hi = li + 1; hipLaunchKernelGGL(hymba_fwd, dim3(grid), dim3(NWAVES * 64), LDS_BYTES, stream, a); }
#endif
}
```

```cpp
#include <hip/hip_runtime.h>
#include <hip/hip_cooperative_groups.h>
#include <cstdio>
#include <cstdint>
namespace pg8 {
#define PG8_LAS __attribute__((address_space(3)))
typedef unsigned short bf16_t;
typedef short bf16x8 __attribute__((ext_vector_type(8)));
typedef float f32x4 __attribute__((ext_vector_type(4)));
typedef unsigned u32x4 __attribute__((ext_vector_type(4)));
constexpr int BM = 256, BK = 64, HALF = 128, HTB = HALF * BK * 2  , STAGE_BYTES = 8 * HTB, NXCD = 8, WGM = 8;

__host__ __device__ __forceinline__ int lds_byte(int r, int c) { const int st = (r >> 4) * 2 + (c >> 5), rr = r & 15, cc = c & 31, ob = rr * 64 + cc * 2; return st * 1024 + (ob ^ (((ob >> 9) & 1) << 5)); }
__host__ __device__ __forceinline__ void stage_rc(int b, int& R, int& C) { const int st = b / 1024, sb = b % 1024, swz = sb ^ (((sb >> 9) & 1) << 5); R = (st >> 1) * 16 + swz / 64; C = (st & 1) * 32 + (swz % 64) / 2; }
__host__ __device__ __forceinline__ int perm32(int rho) { const int n = rho >> 4, i = rho & 15; return 8 * (i >> 2) + 4 * n + (i & 3); }

struct Unit { int pm, pn; };
struct Gemm { const bf16_t* A; const bf16_t* Bt; int M, N, K; };

struct StaticOrder {
    int nM, nN, nwg, G, c;
    __host__ __device__ void init(int M, int N, int G_, int c_) { nM = M / BM; nN = N / BM; nwg = nM * nN; G = G_; c = c_; }
    __host__ __device__ bool next(int i, Unit& u) const {
        const long L = (long)i * G + c; if (L >= nwg) return false;
        int wgid = (int)L; { const int q = nwg / NXCD, r = nwg % NXCD, xcd = wgid % NXCD, off = wgid / NXCD; wgid = (xcd < r ? xcd * (q + 1) : r * (q + 1) + (xcd - r) * q) + off; }
        const int nig = WGM * nN, gid = wgid / nig, fm = gid * WGM, gsz = (nM - fm) < WGM ? (nM - fm) : WGM;
        u.pm = fm + ((wgid % nig) % gsz); u.pn = (wgid % nig) / gsz; return true;
    }
    __device__ __forceinline__ void a_ready(const Unit&) const {}
    __device__ __forceinline__ void done(const Unit&) const {}
};

}
namespace pg8 {
typedef float f32x2c __attribute__((ext_vector_type(2)));
typedef __bf16 bf16x2c __attribute__((ext_vector_type(2)));
__device__ __forceinline__ unsigned cvt_pk_bf16(float lo, float hi) { const bf16x2c r = __builtin_convertvector((f32x2c){lo, hi}, bf16x2c); return __builtin_bit_cast(unsigned, r); }
typedef unsigned u32x4 __attribute__((ext_vector_type(4)));
__device__ __forceinline__ float fsigmoid(float x) { return __builtin_amdgcn_rcpf(1.0f + __expf(-x)); }
struct EpiProj {
    static constexpr bool PERM = true, AFTER_DRAIN = false;
    bf16_t* O; int ldc; const float* b2; const float* lb;
    __device__ __forceinline__ void operator()(const f32x4 (&acc)[2][2][4][2], const Unit& u, int wr, int wc, int fr, int fq) const {
        const int pn = u.pn;
        const int mode = (pn == 0) ? 0 : (pn == 2) ? 2 : (pn == 5 || pn == 6 || pn == 7 || pn == 8 || pn >= 13) ? 3 : (pn == 9 || pn == 10) ? 4 : 1;
        const int row0 = u.pm * BM + wr * 64 + fr; const int col0 = pn * BM + wc * 32 + 8 * fq;
        f32x4 av[2][2];
#pragma unroll
        for (int bj = 0; bj < 2; ++bj)
#pragma unroll
            for (int n = 0; n < 2; ++n) {
                if (mode == 2) av[bj][n] = *(const f32x4*)(b2 + (col0 - 512) + bj * HALF + 4 * n);
                else if (mode == 4) av[bj][n] = *(const f32x4*)(lb + (col0 - 2304) + bj * HALF + 4 * n);
                else av[bj][n] = (f32x4){0.f, 0.f, 0.f, 0.f};
            }
#pragma unroll
        for (int ai = 0; ai < 2; ++ai)
#pragma unroll
            for (int m = 0; m < 4; ++m) { bf16_t* rowp = O + (size_t)(row0 + ai * HALF + m * 16) * ldc + col0;
#pragma unroll
                for (int bj = 0; bj < 2; ++bj) { f32x4 v[2] = {acc[ai][bj][m][0], acc[ai][bj][m][1]};
#pragma unroll
                    for (int n = 0; n < 2; ++n)
#pragma unroll
                        for (int j = 0; j < 4; ++j) { float x = v[n][j];
                            if (mode == 0) x *= 0.125f;
                            else if (mode == 2) { x += av[bj][n][j]; x = (fminf(x, 0.f) - __logf(1.0f + __expf(-fabsf(x)))) * 0.0625f; }
                            else if (mode == 3) x = x * fsigmoid(x);
                            else if (mode == 4) { const float l = av[bj][n][j]; x = __logf(l + (1.0f - l) * fsigmoid(x)); }
                            v[n][j] = x; }
                    u32x4 w; w.x = cvt_pk_bf16(v[0][0], v[0][1]); w.y = cvt_pk_bf16(v[0][2], v[0][3]); w.z = cvt_pk_bf16(v[1][0], v[1][1]); w.w = cvt_pk_bf16(v[1][2], v[1][3]);
                    *(u32x4*)(rowp + bj * HALF) = w; } }
    }
};
struct EpiRelu2 {
    static constexpr bool PERM = true, AFTER_DRAIN = false;
    bf16_t* O; int ldc;
    __device__ __forceinline__ void operator()(const f32x4 (&acc)[2][2][4][2], const Unit& u, int wr, int wc, int fr, int fq) const {
        const int row0 = u.pm * BM + wr * 64 + fr; const int col0 = u.pn * BM + wc * 32 + 8 * fq;
#pragma unroll
        for (int ai = 0; ai < 2; ++ai)
#pragma unroll
            for (int m = 0; m < 4; ++m) { bf16_t* rowp = O + (size_t)(row0 + ai * HALF + m * 16) * ldc + col0;
#pragma unroll
                for (int bj = 0; bj < 2; ++bj) { f32x4 v0 = acc[ai][bj][m][0], v1 = acc[ai][bj][m][1];
#pragma unroll
                    for (int j = 0; j < 4; ++j) { const float a = fmaxf(v0[j], 0.f), b = fmaxf(v1[j], 0.f); v0[j] = a * a; v1[j] = b * b; }
                    u32x4 w; w.x = cvt_pk_bf16(v0[0], v0[1]); w.y = cvt_pk_bf16(v0[2], v0[3]); w.z = cvt_pk_bf16(v1[0], v1[1]); w.w = cvt_pk_bf16(v1[2], v1[3]);
                    *(u32x4*)(rowp + bj * HALF) = w; } }
    }
};
struct EpiRes {
    static constexpr bool PERM = false, AFTER_DRAIN = false;
    const float* base; float* out; int ldc; const float* gate; int gate_ld; int rows_per_batch;
    __device__ __forceinline__ void operator()(const f32x4 (&acc)[2][2][4][2], const Unit& u, int wr, int wc, int fr, int fq) const {
        const int row0 = u.pm * BM + wr * 64 + fr; const int col0 = u.pn * BM + wc * 32 + 4 * fq;
        const float* g = gate + (size_t)((u.pm * BM) / rows_per_batch) * gate_ld + col0;
        f32x4 gv[2][2];
#pragma unroll
        for (int bj = 0; bj < 2; ++bj)
#pragma unroll
            for (int n = 0; n < 2; ++n) gv[bj][n] = *(const f32x4*)(g + bj * HALF + n * 16);
#pragma unroll
        for (int ai = 0; ai < 2; ++ai)
#pragma unroll
            for (int m = 0; m < 4; ++m) { const size_t off = (size_t)(row0 + ai * HALF + m * 16) * ldc + col0;
#pragma unroll
                for (int bj = 0; bj < 2; ++bj)
#pragma unroll
                    for (int n = 0; n < 2; ++n) { const f32x4 bs = *(const f32x4*)(base + off + bj * HALF + n * 16);
                        *(f32x4*)(out + off + bj * HALF + n * 16) = bs + gv[bj][n] * acc[ai][bj][m][n]; } }
    }
};
}
namespace pg8 {
template <class Epi, class Sched, bool ALIGN_EPI = false, bool SP2 = false>
__device__ __forceinline__ void gemm_phase(PG8_LAS unsigned char* lds, const Gemm g, const Sched& S, const Epi& E) {
    const int tid = threadIdx.x, wid = __builtin_amdgcn_readfirstlane(tid >> 6), lane = tid & 63, wr = wid >> 2, wc = wid & 3, fr = lane & 15, fq = lane >> 4;
    const int K = g.K, nt = K / BK;
    unsigned voffA[2], voffB[2];
#pragma unroll
    for (int i = 0; i < 2; ++i) { int R, C; stage_rc(tid * 16 + i * 8192, R, C); const int Rb = Epi::PERM ? ((R & ~31) + perm32(R & 31)) : R;
        voffA[i] = (unsigned)(R * K + C) * 2u; voffB[i] = (unsigned)(Rb * K + C) * 2u; }
    const size_t kstep = (size_t)(BK * 2);
    const size_t hstep = (size_t)HALF * K * 2;
    const size_t tstep = 2 * hstep;
    const unsigned ldsw = (unsigned)wid * 1024u;
    const int aoff = lds_byte(wr * 64 + fr, fq * 8), boff = lds_byte(wc * 32 + fr, fq * 8);
#define PG8_SA(b, h) (((b) * 2 + (h)) * HTB)
#define PG8_SB(b, h) ((4 + (b) * 2 + (h)) * HTB)
#define PG8_STAGE(bufoff, gbase, voff) do { _Pragma("unroll") for (int _i = 0; _i < 2; ++_i) \
        __builtin_amdgcn_global_load_lds((const unsigned*)((const char*)(gbase) + (voff)[_i]), (PG8_LAS unsigned*)(lds + (bufoff) + ldsw + _i * 8192), 16, 0, 0); } while (0)
#define PG8_LDA(dst, b, h) do { _Pragma("unroll") for (int m = 0; m < 4; ++m) _Pragma("unroll") for (int k = 0; k < 2; ++k) dst[m][k] = *(const PG8_LAS bf16x8*)(lds + PG8_SA(b, h) + aoff + m * 2048 + k * 1024); } while (0)
#define PG8_LDB(dst, b, h) do { _Pragma("unroll") for (int n = 0; n < 2; ++n) _Pragma("unroll") for (int k = 0; k < 2; ++k) dst[n][k] = *(const PG8_LAS bf16x8*)(lds + PG8_SB(b, h) + boff + n * 2048 + k * 1024); } while (0)
#define PG8_MMA(ai, bj, At, Bt) do { __builtin_amdgcn_s_setprio(1); _Pragma("unroll") for (int m = 0; m < 4; ++m) _Pragma("unroll") for (int n = 0; n < 2; ++n) _Pragma("unroll") for (int k = 0; k < 2; ++k) \
        acc[ai][bj][m][n] = __builtin_amdgcn_mfma_f32_16x16x32_bf16(Bt[n][k], At[m][k], acc[ai][bj][m][n], 0, 0, 0); __builtin_amdgcn_s_setprio(0); } while (0)
#define PG8_WAIT_V(n) asm volatile("s_waitcnt vmcnt(" #n ")" ::: "memory")
#define PG8_WAIT_L(n) asm volatile("s_waitcnt lgkmcnt(" #n ")" ::: "memory")
#define PG8_BAR __builtin_amdgcn_s_barrier()
#define PG8_SCHED __builtin_amdgcn_sched_barrier(0)
    Unit cur, nxt; int ui = 0;
    if (!S.next(0, cur)) return;
    f32x4 acc[2][2][4][2];
#pragma unroll
    for (int a = 0; a < 2; ++a)
#pragma unroll
        for (int b = 0; b < 2; ++b)
#pragma unroll
            for (int m = 0; m < 4; ++m)
#pragma unroll
                for (int n = 0; n < 2; ++n) acc[a][b][m][n] = (f32x4){0.f, 0.f, 0.f, 0.f};
    bf16x8 At[4][2], B0[2][2], B1[2][2];
    const char* cA = (const char*)g.A + (size_t)cur.pm * tstep; const char* cB = (const char*)g.Bt + (size_t)cur.pn * tstep;
    S.a_ready(cur);
    if constexpr (SP2) {
        PG8_STAGE(PG8_SB(0, 0), cB, voffB); PG8_STAGE(PG8_SB(0, 1), cB + hstep, voffB); PG8_STAGE(PG8_SA(0, 0), cA, voffA); PG8_STAGE(PG8_SA(0, 1), cA + hstep, voffA);
        if (wr == 1) PG8_BAR;
        PG8_WAIT_V(2); PG8_BAR;
        PG8_STAGE(PG8_SB(1, 0), cB + kstep, voffB); PG8_STAGE(PG8_SA(1, 0), cA + kstep, voffA); PG8_STAGE(PG8_SB(1, 1), cB + hstep + kstep, voffB);
        PG8_WAIT_V(6); PG8_BAR;
    } else {
        PG8_STAGE(PG8_SB(0, 0), cB, voffB); PG8_STAGE(PG8_SA(0, 0), cA, voffA); PG8_STAGE(PG8_SB(0, 1), cB + hstep, voffB); PG8_STAGE(PG8_SA(0, 1), cA + hstep, voffA);
        if (wr == 1) PG8_BAR;
        PG8_WAIT_V(4); PG8_BAR;
        PG8_STAGE(PG8_SB(1, 0), cB + kstep, voffB); PG8_STAGE(PG8_SA(1, 0), cA + kstep, voffA); PG8_STAGE(PG8_SB(1, 1), cB + hstep + kstep, voffB);
        PG8_WAIT_V(6); PG8_BAR;
    }
    for (;;) {
        const bool has_next = S.next(ui + 1, nxt);
        const char* nA = has_next ? (const char*)g.A + (size_t)nxt.pm * tstep : cA; const char* nB = has_next ? (const char*)g.Bt + (size_t)nxt.pn * tstep : cB;
        for (int t = 0; t < nt; t += 2) {
            const bool last = (t == nt - 2);
            const char* a1 = cA + (size_t)(t + 1) * kstep;
            const char* a2 = last ? nA : cA + (size_t)(t + 2) * kstep; const char* b2 = last ? nB : cB + (size_t)(t + 2) * kstep;
            const char* a3 = a2 + kstep; const char* b3 = b2 + kstep;
            if (last && has_next) S.a_ready(nxt);
            if constexpr (SP2) {
            PG8_LDB(B0, 0, 0); PG8_LDB(B1, 0, 1); PG8_SCHED; PG8_LDA(At, 0, 0); PG8_STAGE(PG8_SA(1, 1), a1 + hstep, voffA);
            PG8_WAIT_V(8); PG8_WAIT_L(0); PG8_BAR; PG8_MMA(0, 0, At, B0); PG8_MMA(0, 1, At, B1); PG8_BAR; PG8_SCHED;
            PG8_LDA(At, 0, 1); PG8_STAGE(PG8_SB(0, 0), b2, voffB); PG8_STAGE(PG8_SB(0, 1), b2 + hstep, voffB); PG8_STAGE(PG8_SA(0, 0), a2, voffA);
            PG8_WAIT_V(8); PG8_WAIT_L(0); PG8_BAR; PG8_MMA(1, 0, At, B0); PG8_MMA(1, 1, At, B1); PG8_BAR; PG8_SCHED;
            PG8_LDB(B0, 1, 0); PG8_LDB(B1, 1, 1); PG8_SCHED; PG8_LDA(At, 1, 0); PG8_STAGE(PG8_SA(0, 1), a2 + hstep, voffA);
            PG8_WAIT_V(8); PG8_WAIT_L(0); PG8_BAR; PG8_MMA(0, 0, At, B0); PG8_MMA(0, 1, At, B1); PG8_BAR; PG8_SCHED;
            PG8_LDA(At, 1, 1); PG8_STAGE(PG8_SB(1, 0), b3, voffB); PG8_STAGE(PG8_SB(1, 1), b3 + hstep, voffB); PG8_STAGE(PG8_SA(1, 0), a3, voffA);
            PG8_WAIT_V(8); PG8_WAIT_L(0); PG8_BAR; PG8_MMA(1, 0, At, B0); PG8_MMA(1, 1, At, B1); PG8_BAR; PG8_SCHED;
            } else {
            PG8_LDB(B0, 0, 0); PG8_SCHED; PG8_LDA(At, 0, 0); PG8_STAGE(PG8_SA(1, 1), a1 + hstep, voffA);
            PG8_WAIT_L(8); PG8_BAR; PG8_WAIT_L(0); PG8_MMA(0, 0, At, B0); PG8_BAR; PG8_SCHED;
            PG8_LDB(B1, 0, 1); PG8_STAGE(PG8_SB(0, 0), b2, voffB);
            PG8_BAR; PG8_WAIT_L(0); PG8_MMA(0, 1, At, B1); PG8_BAR;
            PG8_LDA(At, 0, 1); PG8_STAGE(PG8_SA(0, 0), a2, voffA);
            PG8_BAR; PG8_WAIT_L(0); PG8_MMA(1, 0, At, B0); PG8_BAR; PG8_SCHED;
            PG8_STAGE(PG8_SB(0, 1), b2 + hstep, voffB);
            PG8_WAIT_V(6); PG8_BAR; PG8_MMA(1, 1, At, B1); PG8_BAR;
            PG8_LDB(B0, 1, 0); PG8_SCHED; PG8_LDA(At, 1, 0); PG8_STAGE(PG8_SA(0, 1), a2 + hstep, voffA);
            PG8_WAIT_L(8); PG8_BAR; PG8_WAIT_L(0); PG8_MMA(0, 0, At, B0); PG8_BAR; PG8_SCHED;
            PG8_LDB(B1, 1, 1); PG8_STAGE(PG8_SB(1, 0), b3, voffB);
            PG8_BAR; PG8_WAIT_L(0); PG8_MMA(0, 1, At, B1); PG8_BAR;
            PG8_LDA(At, 1, 1); PG8_STAGE(PG8_SA(1, 0), a3, voffA);
            PG8_BAR; PG8_WAIT_L(0); PG8_MMA(1, 0, At, B0); PG8_BAR; PG8_SCHED;
            PG8_STAGE(PG8_SB(1, 1), b3 + hstep, voffB);
            PG8_WAIT_V(6); PG8_BAR; PG8_MMA(1, 1, At, B1); PG8_BAR;
            }
        }
        if constexpr (ALIGN_EPI) { if (wr == 0) PG8_BAR; }
        if constexpr (!Epi::AFTER_DRAIN) { E(acc, cur, wr, wc, fr, fq); S.done(cur); }
        if (!has_next) break;
#pragma unroll
        for (int a = 0; a < 2; ++a)
#pragma unroll
            for (int b = 0; b < 2; ++b)
#pragma unroll
                for (int m = 0; m < 4; ++m)
#pragma unroll
                    for (int n = 0; n < 2; ++n) acc[a][b][m][n] = (f32x4){0.f, 0.f, 0.f, 0.f};
        cur = nxt; cA = nA; cB = nB; ++ui;
        if constexpr (ALIGN_EPI) { if (wr == 1) PG8_BAR; }
    }
    PG8_WAIT_V(0);
    if constexpr (!ALIGN_EPI) { if (wr == 0) PG8_BAR; }
    PG8_BAR;
    if constexpr (Epi::AFTER_DRAIN) { E.fused(acc, cur, wr, wc, fr, fq, lds, wid, lane); S.done(cur); }
#undef PG8_SA
#undef PG8_SB
#undef PG8_STAGE
#undef PG8_LDA
#undef PG8_LDB
#undef PG8_MMA
#undef PG8_WAIT_V
#undef PG8_WAIT_L
#undef PG8_BAR
#undef PG8_SCHED
}
}
constexpr int NWAVES = 8;
constexpr int BATCH = 8, T = 4096, D = 1024, M = BATCH * T, FF = 4096, NPROJ = 3840, NMOD = 6 * D, INW = 3600;
constexpr float EPS = 1e-6f;
constexpr size_t MiB = 1u << 20;
constexpr size_t WS_CTL = 0, CTL_ZERO_BYTES = 64 * 1024;
constexpr size_t WS_MOD = 1 * MiB, WS_LB = 1 * MiB + 256 * 1024;
constexpr size_t WS_WIN = 2 * MiB, WS_WOUT = 10 * MiB, WS_W1 = 12 * MiB, WS_W2 = 20 * MiB;
constexpr size_t WS_ACT = 32 * MiB;
constexpr size_t WS_PROJ = 96 * MiB;
constexpr size_t WS_END = 372 * MiB;
constexpr int CW_BAR = 1024;
constexpr int RING_BYTES = 131072, LDSCTL_OFF = RING_BYTES, MISC_OFF = LDSCTL_OFF + 320, LDS_BYTES = 147456;
constexpr int N_PHASES = 10;

#define GAS __attribute__((address_space(1)))
#define LAS __attribute__((address_space(3)))
typedef unsigned short bf16;
typedef unsigned v4u __attribute__((ext_vector_type(4)));
typedef unsigned v2u __attribute__((ext_vector_type(2)));
typedef float f32x4 __attribute__((ext_vector_type(4)));
typedef float f32x2 __attribute__((ext_vector_type(2)));
typedef short bf16x8 __attribute__((ext_vector_type(8)));
typedef GAS unsigned gu32;
#define RLX_AGENT __ATOMIC_RELAXED, __HIP_MEMORY_SCOPE_AGENT
#define LDS_WAIT() asm volatile("s_waitcnt lgkmcnt(0)" ::: "memory")
#define VM_WAIT() asm volatile("s_waitcnt vmcnt(0)" ::: "memory")
__device__ __forceinline__ unsigned pk2(float lo, float hi) { return pg8::cvt_pk_bf16(lo, hi); }
__device__ __forceinline__ float bf_lo(unsigned u) { return __uint_as_float(u << 16); }
__device__ __forceinline__ float bf_hi(unsigned u) { return __uint_as_float(u & 0xffff0000u); }
#define XB_TMO      128
#define XB_XCNT(j)  (256  + 64 * (j))
#define XB_XSUB(j)  (1280 + 64 * (j))
#define XB_XGEN(j)  (2304 + 64 * (j))
#define XB_TOP      3328
#define XB_TOPGEN   3392
#define XCD_BAR_WORDS 3456
#define XB_SPIN_CAP (1u << 18)

__device__ __forceinline__ unsigned xb_ld(unsigned* p)              { return __hip_atomic_load(p, __ATOMIC_RELAXED, __HIP_MEMORY_SCOPE_AGENT); }
__device__ __forceinline__ unsigned xb_add(unsigned* p, unsigned v) { return __hip_atomic_fetch_add(p, v, __ATOMIC_RELAXED, __HIP_MEMORY_SCOPE_AGENT); }
__device__ __forceinline__ unsigned xb_xcc_id() { return (unsigned)__builtin_amdgcn_s_getreg((3 << 11) | 20) & 0xFu; }
#define XB_SPIN(cond, bar) do { unsigned _sp = 0; while (cond) { __builtin_amdgcn_s_sleep(1); \
    if ((++_sp & 255u) == 0u) { if (xb_ld(&(bar)[XB_TMO])) break; if (_sp > XB_SPIN_CAP) { atomicAdd(&(bar)[XB_TMO], 1u); break; } } } } while (0)

struct XcdBarrier {
    unsigned* bar; unsigned x;
    volatile LAS unsigned* st;
};

__device__ __forceinline__ XcdBarrier xcd_barrier_post(unsigned* bar, volatile LAS unsigned* st) {
    XcdBarrier b; b.bar = bar; b.x = xb_xcc_id(); b.st = st;
    if (threadIdx.x == 0) (void)xb_add(&bar[XB_XCNT(b.x)], 1u);
    return b;
}
__device__ __forceinline__ void xcd_barrier_complete(unsigned* bar, unsigned x, unsigned& nloc, unsigned& nx) {
    const unsigned G = gridDim.x * gridDim.y * gridDim.z;
    unsigned sum, cnt, mine, sp = 0u;
    for (;;) {
        sum = 0u; cnt = 0u; mine = 0u;
#pragma unroll
        for (unsigned j = 0; j < 16; ++j) { const unsigned c = xb_ld(&bar[XB_XCNT(j)]); sum += c; cnt += (c > 0u) ? 1u : 0u; mine = (j == x) ? c : mine; }
        if (sum == G) break;
        __builtin_amdgcn_s_sleep(1);
        if ((++sp & 255u) == 0u) { if (xb_ld(&bar[XB_TMO])) break; if (sp > XB_SPIN_CAP) { atomicAdd(&bar[XB_TMO], 1u); break; } }
    }
    nloc = mine > 0u ? mine : 1u; nx = cnt > 0u ? cnt : 1u;
}

__device__ __forceinline__ void xcd_barrier(const XcdBarrier& b) {
    asm volatile("s_waitcnt vmcnt(0)" ::: "memory");
    __syncthreads();
    if (threadIdx.x == 0) {
        unsigned* bar = b.bar;
        __builtin_amdgcn_s_waitcnt(0);
        unsigned nloc = b.st[0], nx = b.st[1];
        if (nloc == 0u) { xcd_barrier_complete(bar, b.x, nloc, nx); b.st[0] = nloc; b.st[1] = nx; }
        const unsigned old = xb_add(&bar[XB_XSUB(b.x)], 1u);
        const unsigned gen = old / nloc;
        if (old + 1u == (gen + 1u) * nloc) {
            __builtin_amdgcn_fence(__ATOMIC_RELEASE, "agent");
            asm volatile("s_waitcnt vmcnt(0)" ::: "memory");
            const unsigned og = xb_add(&bar[XB_TOP], 1u);
            const unsigned tg = og / nx;
            if (og + 1u == (tg + 1u) * nx) xb_add(&bar[XB_TOPGEN], 1u);
            else XB_SPIN(xb_ld(&bar[XB_TOPGEN]) == tg, bar);
            __builtin_amdgcn_fence(__ATOMIC_ACQUIRE, "agent");
            xb_add(&bar[XB_XGEN(b.x)], 1u);
            asm volatile("s_waitcnt vmcnt(0)" ::: "memory");
        } else {
            XB_SPIN(xb_ld(&bar[XB_XGEN(b.x)]) == gen, bar);
            __builtin_amdgcn_fence(__ATOMIC_ACQUIRE, "agent");
            asm volatile("s_waitcnt vmcnt(0)" ::: "memory");
        }
    }
    __syncthreads();
}
struct Frame {
    LAS unsigned char* lds;
    int tid, lane, wave, vcu, G;
};
__device__ __forceinline__ float wave_sum(float v) {
#pragma unroll
    for (int o = 1; o < 64; o <<= 1) v += __shfl_xor(v, o);
    return v;
}
__device__ __forceinline__ void transpose_item(const float* W, int ldw, int c0, int K, bf16* WT, int r0, LAS float* scr, int kb, int nb, int lane) {
    const int k0 = 64 * kb, n0 = 32 * nb;
#pragma unroll 8
    for (int i = 0; i < 32; ++i) { const int kk = 2 * i + (lane >> 5); scr[kk * 33 + (lane & 31)] = W[(size_t)(k0 + kk) * ldw + c0 + n0 + (lane & 31)]; }
    LDS_WAIT(); asm volatile("" ::: "memory");
    const int c = lane & 7;
#pragma unroll
    for (int j = 0; j < 4; ++j) { const int n = (lane >> 3) + 8 * j; const LAS float* s = scr + (8 * c) * 33 + n;
        v4u o; o.x = pk2(s[0 * 33], s[1 * 33]); o.y = pk2(s[2 * 33], s[3 * 33]); o.z = pk2(s[4 * 33], s[5 * 33]); o.w = pk2(s[6 * 33], s[7 * 33]);
        *(GAS v4u*)(WT + (size_t)(r0 + n0 + n) * K + k0 + 8 * c) = o; }
    LDS_WAIT(); asm volatile("" ::: "memory");
}
struct Ptrs {
    const float *x, *c, *w_ada, *b_ada, *w_in, *w2g, *b2g, *gla_g, *lb_logits, *hgrn_g, *w_out, *w1, *w2, *fin_g;
    float* out; unsigned char* ws;
};
__device__ __forceinline__ void p0_prologue(const Frame& F, const Ptrs& P) {
    float* MOD = (float*)(P.ws + WS_MOD); float* LB = (float*)(P.ws + WS_LB);
    bf16* WIN = (bf16*)(P.ws + WS_WIN); bf16* WOUT = (bf16*)(P.ws + WS_WOUT); bf16* W1T = (bf16*)(P.ws + WS_W1); bf16* W2T = (bf16*)(P.ws + WS_W2);
    if (blockIdx.x < (unsigned)(NMOD / 64)) {
        LAS float* sc = (LAS float*)F.lds;
        LAS float* red = (LAS float*)(F.lds + 32768);
        for (int i = F.tid; i < BATCH * D; i += 512) { const float v = P.c[i]; sc[i] = v * pg8::fsigmoid(v); }
        __syncthreads();
        for (int jg = blockIdx.x; jg < NMOD / 64; jg += F.G) {
            const int j = jg * 64 + F.lane; float a[BATCH];
#pragma unroll
            for (int b = 0; b < BATCH; ++b) a[b] = 0.f;
            const int kbeg = F.wave * 128;
#pragma unroll 8
            for (int k = kbeg; k < kbeg + 128; ++k) { const float wv = P.w_ada[(size_t)k * NMOD + j];
#pragma unroll
                for (int b = 0; b < BATCH; ++b) a[b] += sc[b * D + k] * wv; }
#pragma unroll
            for (int b = 0; b < BATCH; ++b) red[(F.wave * BATCH + b) * 64 + F.lane] = a[b];
            __syncthreads();
            { const int b = F.tid >> 6; float s = P.b_ada[j];
#pragma unroll
              for (int w = 0; w < 8; ++w) s += red[(w * BATCH + b) * 64 + F.lane];
              MOD[b * NMOD + j] = s; }
            __syncthreads();
        }
    }
    if (blockIdx.x == (unsigned)(F.G - 1)) { for (int i = F.tid; i < 512; i += 512) { const float l0 = P.lb_logits[i], l1 = P.lb_logits[512 + i]; const float mx = fmaxf(l0, l1); const float e0 = __expf(l0 - mx), e1 = __expf(l1 - mx); LB[i] = e0 / (e0 + e1); } }
    __syncthreads();
    LAS float* scr = (LAS float*)(F.lds + F.wave * 16384);
    const int gw = F.vcu * NWAVES + F.wave, NGW = F.G * NWAVES;
    constexpr int KB1 = D / 64;
    constexpr int I_A = KB1 * (512 / 32), I_B = KB1 * (512 / 32), I_C = KB1 * (2560 / 32), I_O = KB1 * (D / 32), I_1 = KB1 * (FF / 32), I_2 = (FF / 64) * (D / 32);
    constexpr int I_G = 256 * 128 / 64;
    constexpr int NITEMS = I_A + I_B + I_C + I_O + I_1 + I_2 + I_G;
    for (int it = gw; it < NITEMS; it += NGW) {
        int r = it;
        if (r < I_A) { transpose_item(P.w_in, INW, 0, D, WIN, 0, scr, r / 16, r % 16, F.lane); continue; } r -= I_A;
        if (r < I_B) { transpose_item(P.w_in, INW, 512, D, WIN, 768, scr, r / 16, r % 16, F.lane); continue; } r -= I_B;
        if (r < I_C) { transpose_item(P.w_in, INW, 1040, D, WIN, 1280, scr, r / 80, r % 80, F.lane); continue; } r -= I_C;
        if (r < I_O) { transpose_item(P.w_out, D, 0, D, WOUT, 0, scr, r / 32, r % 32, F.lane); continue; } r -= I_O;
        if (r < I_1) { transpose_item(P.w1, FF, 0, D, W1T, 0, scr, r / 128, r % 128, F.lane); continue; } r -= I_1;
        if (r < I_2) { transpose_item(P.w2, D, 0, FF, W2T, 0, scr, r / 32, r % 32, F.lane); continue; } r -= I_2;
        {
            const int idx = r * 64 + F.lane, n = idx >> 7, ko = idx & 127;
            float wr[16];
#pragma unroll
            for (int q = 0; q < 16; ++q) wr[q] = P.w2g[q * 256 + n];
            float o[8];
#pragma unroll
            for (int kk = 0; kk < 8; ++kk) { const float* src = P.w_in + (size_t)(ko * 8 + kk) * INW + 1024; float s = 0.f;
#pragma unroll
                for (int q4 = 0; q4 < 4; ++q4) { const f32x4 v = *(const f32x4*)(src + 4 * q4); s += v[0] * wr[4 * q4] + v[1] * wr[4 * q4 + 1] + v[2] * wr[4 * q4 + 2] + v[3] * wr[4 * q4 + 3]; }
                o[kk] = s; }
            v4u w; w.x = pk2(o[0], o[1]); w.y = pk2(o[2], o[3]); w.z = pk2(o[4], o[5]); w.w = pk2(o[6], o[7]);
            *(GAS v4u*)(WIN + (size_t)(512 + n) * D + ko * 8) = w;
        }
    }
}
__device__ __forceinline__ void rows_modulate(const Frame& F, const float* src, bf16* dst, const float* shift, const float* scale) {
    const int gw = F.vcu * NWAVES + F.wave, NGW = F.G * NWAVES;
    for (int m = gw; m < M; m += NGW) {
        const GAS f32x4* xr = (const GAS f32x4*)(src + (size_t)m * D) + F.lane;
        const int b = m / T;
        f32x4 v[4]; float s = 0.f;
#pragma unroll
        for (int j = 0; j < 4; ++j) { v[j] = xr[64 * j]; s += (v[j].x * v[j].x + v[j].y * v[j].y) + (v[j].z * v[j].z + v[j].w * v[j].w); }
        const float rstd = rsqrtf(wave_sum(s) * (1.f / D) + EPS);
        GAS v2u* o8 = (GAS v2u*)(dst + (size_t)m * D) + F.lane;
#pragma unroll
        for (int j = 0; j < 4; ++j) { const f32x4 sc = *((const f32x4*)(scale + (size_t)b * NMOD) + F.lane + 64 * j), sh = *((const f32x4*)(shift + (size_t)b * NMOD) + F.lane + 64 * j);
            const f32x4 h = v[j] * rstd * (sc + 1.0f) + sh; v2u w; w.x = pk2(h.x, h.y); w.y = pk2(h.z, h.w); o8[64 * j] = w; }
    }
}
__device__ __forceinline__ void rows_final(const Frame& F, float* buf, const float* g) {
    const int gw = F.vcu * NWAVES + F.wave, NGW = F.G * NWAVES;
    f32x4 gv[4];
#pragma unroll
    for (int j = 0; j < 4; ++j) gv[j] = *((const f32x4*)g + F.lane + 64 * j);
    for (int m = gw; m < M; m += NGW) {
        GAS f32x4* xr = (GAS f32x4*)(buf + (size_t)m * D) + F.lane;
        f32x4 v[4]; float s = 0.f;
#pragma unroll
        for (int j = 0; j < 4; ++j) { v[j] = xr[64 * j]; s += (v[j].x * v[j].x + v[j].y * v[j].y) + (v[j].z * v[j].z + v[j].w * v[j].w); }
        const float rstd = rsqrtf(wave_sum(s) * (1.f / D) + EPS);
#pragma unroll
        for (int j = 0; j < 4; ++j) xr[64 * j] = v[j] * rstd * gv[j];
    }
}
#ifndef SCAN_PREFETCH
#define SCAN_PREFETCH 1
#endif
constexpr int NQ = 4, CPQ = (T / 64) / NQ;
constexpr size_t WS_SLOC = 352 * MiB;
constexpr size_t WS_LSUM = 370 * MiB;
template <int DK, bool HGRN, int MODE>
__device__ __forceinline__ void scan_item(LAS unsigned char* lds, const bf16* PROJ, bf16* OMIX, const float* gain, float* SLOC, float* LSUM, int item, int q, int b, int qc, int kc, int lac, int vc, int gc, int oc, int tid) {
    constexpr int DKP = DK + 8, NP = DK / 2, NSEG = 512 / NP, TL = 64 / NSEG, NDB = DK / 16, NKS = DK / 32;
    constexpr int OFF_QR = 0, OFF_KR = OFF_QR + 64 * DKP * 2, OFF_KRT = OFF_KR + 64 * DKP * 2, OFF_VT = OFF_KRT + DK * 144, OFF_P = OFF_VT + 128 * 144, OFF_ST = OFF_P + 64 * 144,
                  OFF_SEG = OFF_ST + 128 * DKP * 2, OFF_VEC = OFF_SEG + NSEG * DK * 4, OFF_RMS = OFF_VEC + 3 * DK * 4, OFF_END = OFF_RMS + 2 * 64 * 4;
    static_assert(OFF_END <= RING_BYTES, "scan LDS");
    constexpr float LOG2E = 1.4426950408889634f;
    const int lane = tid & 63, w = __builtin_amdgcn_readfirstlane(tid >> 6), l15 = lane & 15, lq = lane >> 4;
    const int p = tid % NP, seg = tid / NP, t0 = seg * TL;
    const int ep = tid & 63, sseg = tid >> 6;
    const int tb = w & 3, eh = w >> 2;
    f32x4 S[NDB];
#pragma unroll
    for (int i = 0; i < NDB; ++i) S[i] = (f32x4){0.f, 0.f, 0.f, 0.f};
    if (MODE == 1) {
        for (int j = 0; j < q; ++j) { const float* sl = SLOC + ((size_t)((item * NQ + j) * 8) * 8 + w) * 256 + lane * 4; const float* ls = LSUM + (size_t)(item * NQ + j) * 128 + 4 * lq;
#pragma unroll
            for (int db = 0; db < NDB; ++db) { const f32x4 sv = *(const f32x4*)(sl + (size_t)db * 8 * 256); const f32x4 lv = *(const f32x4*)(ls + db * 16);
                const f32x4 dv = (f32x4){__builtin_amdgcn_exp2f(lv[0]), __builtin_amdgcn_exp2f(lv[1]), __builtin_amdgcn_exp2f(lv[2]), __builtin_amdgcn_exp2f(lv[3])};
                S[db] = dv * S[db] + sv; } }
    }
    f32x2 lacc = (f32x2){0.f, 0.f};
    const unsigned toff = (unsigned)(t0 * NPROJ + 2 * p) * 2u, voff = (unsigned)(8 * sseg * NPROJ + vc + 2 * ep) * 2u, goff = (unsigned)((tb * 16 + l15) * NPROJ + gc + eh * 64 + 4 * lq) * 2u;
    const unsigned ooff = (unsigned)((tb * 16 + l15) * D + oc + eh * 64 + 4 * lq) * 2u;
    unsigned ula[TL], uq[TL], uk[TL], uv[8];
#define SCAN_LOADS(cbp) do { _Pragma("unroll") for (int i = 0; i < TL; ++i) { ula[i] = *(const unsigned*)((cbp) + (size_t)(i * NPROJ + lac) * 2 + toff); \
            if (MODE == 1) uq[i] = *(const unsigned*)((cbp) + (size_t)(i * NPROJ + qc) * 2 + toff); else uq[i] = 0u; \
            if (!HGRN) uk[i] = *(const unsigned*)((cbp) + (size_t)(i * NPROJ + kc) * 2 + toff); else uk[i] = 0u; } \
        _Pragma("unroll") for (int i = 0; i < 8; ++i) uv[i] = *(const unsigned*)((cbp) + (size_t)(i * NPROJ) * 2 + voff); } while (0)
    const int c0 = q * CPQ;
    { const char* cb0 = (const char*)PROJ + ((size_t)b * T + (size_t)c0 * 64) * (size_t)(NPROJ * 2); SCAN_LOADS(cb0); }
    for (int c = c0; c < c0 + CPQ; ++c) {
        const size_t row0 = (size_t)b * T + (size_t)c * 64;
        const char* cb = (const char*)PROJ + row0 * (size_t)(NPROJ * 2);
#if !SCAN_PREFETCH
        if (c > c0) SCAN_LOADS(cb);
#endif
        v2u ugate[4];
        if (MODE == 1) {
#pragma unroll
            for (int j = 0; j < 4; ++j) ugate[j] = *(const v2u*)(cb + (size_t)(j * 32) + goff); }
        f32x2 cl[TL]; f32x2 run = (f32x2){0.f, 0.f};
#pragma unroll
        for (int i = 0; i < TL; ++i) { run.x += bf_lo(ula[i]) * LOG2E; run.y += bf_hi(ula[i]) * LOG2E; cl[i] = run; }
        *(LAS f32x2*)(lds + OFF_SEG + (seg * DK + 2 * p) * 4) = run;
        { v4u a, bq; a.x = (uv[0] & 0xffffu) | (uv[1] << 16); a.y = (uv[2] & 0xffffu) | (uv[3] << 16); a.z = (uv[4] & 0xffffu) | (uv[5] << 16); a.w = (uv[6] & 0xffffu) | (uv[7] << 16);
          bq.x = (uv[0] >> 16) | (uv[1] & 0xffff0000u); bq.y = (uv[2] >> 16) | (uv[3] & 0xffff0000u); bq.z = (uv[4] >> 16) | (uv[5] & 0xffff0000u); bq.w = (uv[6] >> 16) | (uv[7] & 0xffff0000u);
          *(LAS v4u*)(lds + OFF_VT + (2 * ep) * 144 + sseg * 16) = a; *(LAS v4u*)(lds + OFF_VT + (2 * ep + 1) * 144 + sseg * 16) = bq; }
        __syncthreads();
        f32x2 pre = (f32x2){0.f, 0.f}, mid = (f32x2){0.f, 0.f}, last = (f32x2){0.f, 0.f};
#pragma unroll
        for (int j = 0; j < NSEG; ++j) { const f32x2 tj = *(const LAS f32x2*)(lds + OFF_SEG + (j * DK + 2 * p) * 4);
            if (j < seg) pre += tj; if (j < NSEG / 2) mid += tj; last += tj; }
        if (seg == 0) { LAS float* vec = (LAS float*)(lds + OFF_VEC);
            *(LAS f32x2*)(vec + 2 * p) = (f32x2){__builtin_amdgcn_exp2f(mid.x), __builtin_amdgcn_exp2f(mid.y)};
            *(LAS f32x2*)(vec + DK + 2 * p) = (f32x2){__builtin_amdgcn_exp2f(last.x - mid.x), __builtin_amdgcn_exp2f(last.y - mid.y)};
            *(LAS f32x2*)(vec + 2 * DK + 2 * p) = (f32x2){__builtin_amdgcn_exp2f(last.x), __builtin_amdgcn_exp2f(last.y)}; }
        if (MODE == 0) lacc += last;
        unsigned kt0[TL / 2], kt1[TL / 2];
#pragma unroll
        for (int i = 0; i < TL; i += 2) {
            float krx[2], kry[2];
#pragma unroll
            for (int ii = 0; ii < 2; ++ii) { const int i2 = i + ii;
                const float cx = pre.x + cl[i2].x, cy = pre.y + cl[i2].y;
                const float bx = __builtin_amdgcn_exp2f(mid.x - cx), by = __builtin_amdgcn_exp2f(mid.y - cy);
                float kx, ky;
                if (HGRN) { kx = 1.0f - __builtin_amdgcn_exp2f(bf_lo(ula[i2]) * LOG2E); ky = 1.0f - __builtin_amdgcn_exp2f(bf_hi(ula[i2]) * LOG2E); }
                else { kx = bf_lo(uk[i2]); ky = bf_hi(uk[i2]); }
                krx[ii] = kx * bx; kry[ii] = ky * by;
                if (MODE == 1) { const float ax = __builtin_amdgcn_exp2f(cx - mid.x), ay = __builtin_amdgcn_exp2f(cy - mid.y);
                    const float qx = bf_lo(uq[i2]) * ax, qy = bf_hi(uq[i2]) * ay;
                    *(LAS unsigned*)(lds + OFF_QR + (t0 + i2) * (DKP * 2) + 4 * p) = pk2(qx, qy);
                    *(LAS unsigned*)(lds + OFF_KR + (t0 + i2) * (DKP * 2) + 4 * p) = pk2(krx[ii], kry[ii]); } }
            kt0[i / 2] = pk2(krx[0], krx[1]); kt1[i / 2] = pk2(kry[0], kry[1]);
        }
        if (TL == 8) { *(LAS v4u*)(lds + OFF_KRT + (2 * p) * 144 + t0 * 2) = (v4u){kt0[0], kt0[1], kt0[2 % (TL / 2)], kt0[3 % (TL / 2)]};
                       *(LAS v4u*)(lds + OFF_KRT + (2 * p + 1) * 144 + t0 * 2) = (v4u){kt1[0], kt1[1], kt1[2 % (TL / 2)], kt1[3 % (TL / 2)]}; }
        else { *(LAS v2u*)(lds + OFF_KRT + (2 * p) * 144 + t0 * 2) = (v2u){kt0[0], kt0[1]}; *(LAS v2u*)(lds + OFF_KRT + (2 * p + 1) * 144 + t0 * 2) = (v2u){kt1[0], kt1[1]}; }
#if SCAN_PREFETCH
        { const char* cbn = (c + 1 < c0 + CPQ) ? cb + (size_t)64 * NPROJ * 2 : cb; SCAN_LOADS(cbn); }
#endif
        __syncthreads();
        if (MODE == 1) {
#pragma unroll
        for (int db = 0; db < NDB; ++db) { const f32x4 em = *(const LAS f32x4*)(lds + OFF_VEC + (db * 16 + 4 * lq) * 4); const f32x4 v = S[db] * em;
            *(LAS v2u*)(lds + OFF_ST + (w * 16 + l15) * (DKP * 2) + (db * 16 + 4 * lq) * 2) = (v2u){pk2(v[0], v[1]), pk2(v[2], v[3])}; }
#pragma unroll
        for (int h2 = 0; h2 < 2; ++h2) { const int id = w + 8 * h2, ti = id >> 2, si = id & 3;
            f32x4 acc = (f32x4){0.f, 0.f, 0.f, 0.f};
            if (si <= ti) {
#pragma unroll
                for (int ks = 0; ks < NKS; ++ks) { const bf16x8 a = *(const LAS bf16x8*)(lds + OFF_KR + (si * 16 + l15) * (DKP * 2) + (ks * 32 + 8 * lq) * 2);
                    const bf16x8 bb = *(const LAS bf16x8*)(lds + OFF_QR + (ti * 16 + l15) * (DKP * 2) + (ks * 32 + 8 * lq) * 2);
                    acc = __builtin_amdgcn_mfma_f32_16x16x32_bf16(a, bb, acc, 0, 0, 0); }
                if (si == ti) {
#pragma unroll
                    for (int r = 0; r < 4; ++r) if (4 * lq + r > l15) acc[r] = 0.f; }
            }
            *(LAS v2u*)(lds + OFF_P + (ti * 16 + l15) * 144 + (si * 16 + 4 * lq) * 2) = (v2u){pk2(acc[0], acc[1]), pk2(acc[2], acc[3])};
        }
        __syncthreads();
        }
        f32x4 o[4];
        if (MODE == 1) { bf16x8 pB[2], qB[NKS];
#pragma unroll
          for (int ks = 0; ks < 2; ++ks) pB[ks] = *(const LAS bf16x8*)(lds + OFF_P + (tb * 16 + l15) * 144 + (ks * 32 + 8 * lq) * 2);
#pragma unroll
          for (int ks = 0; ks < NKS; ++ks) qB[ks] = *(const LAS bf16x8*)(lds + OFF_QR + (tb * 16 + l15) * (DKP * 2) + (ks * 32 + 8 * lq) * 2);
#pragma unroll
          for (int j = 0; j < 4; ++j) { const int eb = eh * 4 + j; f32x4 acc = (f32x4){0.f, 0.f, 0.f, 0.f};
#pragma unroll
              for (int ks = 0; ks < 2; ++ks) { const bf16x8 a = *(const LAS bf16x8*)(lds + OFF_VT + (eb * 16 + l15) * 144 + (ks * 32 + 8 * lq) * 2); acc = __builtin_amdgcn_mfma_f32_16x16x32_bf16(a, pB[ks], acc, 0, 0, 0); }
#pragma unroll
              for (int ks = 0; ks < NKS; ++ks) { const bf16x8 a = *(const LAS bf16x8*)(lds + OFF_ST + (eb * 16 + l15) * (DKP * 2) + (ks * 32 + 8 * lq) * 2); acc = __builtin_amdgcn_mfma_f32_16x16x32_bf16(a, qB[ks], acc, 0, 0, 0); }
              o[j] = acc; } }
        { bf16x8 vB[2];
#pragma unroll
          for (int ks = 0; ks < 2; ++ks) vB[ks] = *(const LAS bf16x8*)(lds + OFF_VT + (w * 16 + l15) * 144 + (ks * 32 + 8 * lq) * 2);
#pragma unroll
          for (int db = 0; db < NDB; ++db) { f32x4 acc = (f32x4){0.f, 0.f, 0.f, 0.f};
#pragma unroll
              for (int ks = 0; ks < 2; ++ks) { const bf16x8 a = *(const LAS bf16x8*)(lds + OFF_KRT + (db * 16 + l15) * 144 + (ks * 32 + 8 * lq) * 2); acc = __builtin_amdgcn_mfma_f32_16x16x32_bf16(a, vB[ks], acc, 0, 0, 0); }
              const f32x4 gg = *(const LAS f32x4*)(lds + OFF_VEC + (DK + db * 16 + 4 * lq) * 4), dec = *(const LAS f32x4*)(lds + OFF_VEC + (2 * DK + db * 16 + 4 * lq) * 4);
              S[db] = dec * S[db] + gg * acc; } }
        if (MODE == 1) {
        float ss = 0.f;
#pragma unroll
        for (int j = 0; j < 4; ++j) ss += (o[j][0] * o[j][0] + o[j][1] * o[j][1]) + (o[j][2] * o[j][2] + o[j][3] * o[j][3]);
        ss += __shfl_xor(ss, 16); ss += __shfl_xor(ss, 32);
        if (lane < 16) *(LAS float*)(lds + OFF_RMS + (eh * 64 + tb * 16 + lane) * 4) = ss;
        }
        __syncthreads();
        if (MODE == 1) {
        const float tot = *(const LAS float*)(lds + OFF_RMS + (tb * 16 + l15) * 4) + *(const LAS float*)(lds + OFF_RMS + (64 + tb * 16 + l15) * 4);
        const float rstd = rsqrtf(tot * (1.0f / 128.0f) + EPS);
        char* ob = (char*)OMIX + row0 * (size_t)(D * 2);
#pragma unroll
        for (int j = 0; j < 4; ++j) { const f32x4 gn = *(const f32x4*)(gain + (eh * 4 + j) * 16 + 4 * lq); const f32x4 v = o[j] * rstd * gn;
            *(v2u*)(ob + (size_t)(j * 32) + ooff) = (v2u){pk2(v[0] * bf_lo(ugate[j].x), v[1] * bf_hi(ugate[j].x)), pk2(v[2] * bf_lo(ugate[j].y), v[3] * bf_hi(ugate[j].y))}; }
        }
    }
#undef SCAN_LOADS
    if (MODE == 0) {
        float* sl = SLOC + ((size_t)((item * NQ + q) * 8) * 8 + w) * 256 + lane * 4;
#pragma unroll
        for (int db = 0; db < NDB; ++db) *(f32x4*)(sl + (size_t)db * 8 * 256) = S[db];
        if (seg == 0) *(f32x2*)(LSUM + (size_t)(item * NQ + q) * 128 + 2 * p) = lacc;
    }
}
struct Args { const float* in[14]; float* out; unsigned char* ws; int ph_lo, ph_hi; };
__global__ void __launch_bounds__(NWAVES * 64, 2) hymba_fwd(Args args) {
    extern __shared__ __attribute__((aligned(16))) unsigned char lds_raw[];
    Frame F;
    F.lds = (LAS unsigned char*)lds_raw;
    volatile LAS unsigned* MISC = (volatile LAS unsigned*)(F.lds + MISC_OFF);
    F.tid = threadIdx.x; F.lane = F.tid & 63; F.wave = __builtin_amdgcn_readfirstlane(F.tid >> 6);
    F.G = gridDim.x; { const int bx = blockIdx.x; F.vcu = (F.G % 8 == 0) ? (bx % 8) * (F.G / 8) + bx / 8 : bx; }
    Ptrs P;
    P.x = args.in[0]; P.c = args.in[1]; P.w_ada = args.in[2]; P.b_ada = args.in[3]; P.w_in = args.in[4]; P.w2g = args.in[5]; P.b2g = args.in[6]; P.gla_g = args.in[7];
    P.lb_logits = args.in[8]; P.hgrn_g = args.in[9]; P.w_out = args.in[10]; P.w1 = args.in[11]; P.w2 = args.in[12]; P.fin_g = args.in[13]; P.out = args.out; P.ws = args.ws;
    unsigned char* ws = args.ws;
    const float* MOD = (const float*)(ws + WS_MOD); const float* LB = (const float*)(ws + WS_LB);
    bf16* WIN = (bf16*)(ws + WS_WIN); bf16* WOUT = (bf16*)(ws + WS_WOUT); bf16* W1T = (bf16*)(ws + WS_W1); bf16* W2T = (bf16*)(ws + WS_W2);
    bf16* ACT = (bf16*)(ws + WS_ACT); bf16* PROJ = (bf16*)(ws + WS_PROJ); bf16* HB = (bf16*)(ws + WS_PROJ);
    for (int u = F.tid; u < (LDS_BYTES - LDSCTL_OFF) / 4; u += NWAVES * 64) ((LAS unsigned*)(F.lds + LDSCTL_OFF))[u] = 0u;
    __syncthreads();
    const int lo = args.ph_lo, hi = args.ph_hi;
    const bool single = (hi - lo) > 1;
    XcdBarrier bar; bar.bar = (unsigned*)(ws + WS_CTL) + CW_BAR; bar.x = 0; bar.st = nullptr;
    if (single) bar = xcd_barrier_post((unsigned*)(ws + WS_CTL) + CW_BAR, MISC + 8);
#define IN(k) (lo <= (k) && (k) < hi)
#define SEAM(k) do { if (IN(k) && IN((k) + 1)) xcd_barrier(bar); } while (0)

    if (IN(0)) { p0_prologue(F, P); } SEAM(0);
    if (IN(1)) { rows_modulate(F, P.x, ACT, MOD + 0 * D, MOD + 1 * D); } SEAM(1);
    if (IN(2)) {
        pg8::Gemm g{ACT, WIN, M, NPROJ, D}; pg8::StaticOrder S; S.init(M, NPROJ, F.G, (int)blockIdx.x);
        pg8::EpiProj E{PROJ, NPROJ, P.b2g, LB};
        pg8::gemm_phase<pg8::EpiProj, pg8::StaticOrder, true, true>(F.lds, g, S, E);
    } SEAM(2);
    if (IN(3)) {
        float* SLOC = (float*)(ws + WS_SLOC); float* LSUM = (float*)(ws + WS_LSUM);
        for (int it = blockIdx.x; it < 64 * NQ; it += F.G) { const int item = it >> 2, q = it & 3; const int b = item >> 3, h8 = item & 7; int tidv = F.tid; asm volatile("" : "+v"(tidv));
            if (q < NQ - 1) {
            if (h8 < 4) { const int h = h8; scan_item<64, false, 0>(F.lds, PROJ, ACT, P.gla_g, SLOC, LSUM, item, q, b, h * 64, 256 + h * 64, 512 + h * 64, 768 + h * 128, 1280 + h * 128, h * 128, tidv); }
            else { const int h = h8 - 4; scan_item<128, true, 0>(F.lds, PROJ, ACT, P.hgrn_g, SLOC, LSUM, item, q, b, 1792 + h * 128, 0, 2304 + h * 128, 2816 + h * 128, 3328 + h * 128, 512 + h * 128, tidv); } }
            __syncthreads(); }
    } SEAM(3);
    if (IN(4)) {
        float* SLOC = (float*)(ws + WS_SLOC); float* LSUM = (float*)(ws + WS_LSUM);
        for (int it = blockIdx.x; it < 64 * NQ; it += F.G) { const int item = it >> 2, q = it & 3; const int b = item >> 3, h8 = item & 7; int tidv = F.tid; asm volatile("" : "+v"(tidv));
            if (h8 < 4) { const int h = h8; scan_item<64, false, 1>(F.lds, PROJ, ACT, P.gla_g, SLOC, LSUM, item, q, b, h * 64, 256 + h * 64, 512 + h * 64, 768 + h * 128, 1280 + h * 128, h * 128, tidv); }
            else { const int h = h8 - 4; scan_item<128, true, 1>(F.lds, PROJ, ACT, P.hgrn_g, SLOC, LSUM, item, q, b, 1792 + h * 128, 0, 2304 + h * 128, 2816 + h * 128, 3328 + h * 128, 512 + h * 128, tidv); }
            __syncthreads(); }
    } SEAM(4);
    if (IN(5)) {
        pg8::Gemm g{ACT, WOUT, M, D, D}; pg8::StaticOrder S; S.init(M, D, F.G, (int)blockIdx.x);
        pg8::EpiRes E{P.x, P.out, D, MOD + 2 * D, NMOD, T};
        pg8::gemm_phase<pg8::EpiRes, pg8::StaticOrder, true, true>(F.lds, g, S, E);
    } SEAM(5);
    if (IN(6)) { rows_modulate(F, P.out, ACT, MOD + 3 * D, MOD + 4 * D); } SEAM(6);
    if (IN(7)) {
        pg8::Gemm g{ACT, W1T, M, FF, D}; pg8::StaticOrder S; S.init(M, FF, F.G, (int)blockIdx.x);
        pg8::EpiRelu2 E{HB, FF};
        pg8::gemm_phase<pg8::EpiRelu2, pg8::StaticOrder, true, true>(F.lds, g, S, E);
    } SEAM(7);
    if (IN(8)) {
        pg8::Gemm g{HB, W2T, M, D, FF}; pg8::StaticOrder S; S.init(M, D, F.G, (int)blockIdx.x);
        pg8::EpiRes E{P.out, P.out, D, MOD + 5 * D, NMOD, T};
        pg8::gemm_phase<pg8::EpiRes, pg8::StaticOrder, true, true>(F.lds, g, S, E);
    } SEAM(8);
    if (IN(9)) { rows_final(F, P.out, P.fin_g); }
#undef IN
#undef SEAM
}

#ifndef MK_N_LAUNCHES
#define MK_N_LAUNCHES 1
#endif
extern "C" void kernel_launch(void* const* d_in, const int* in_sizes, int n_in, void* d_out, int out_size, void* d_ws, size_t ws_size, hipStream_t stream) {
    static int grid = 0;
    if (grid == 0) {
        if (n_in != 14 || out_size != M * D || ws_size < WS_END) { fprintf(stderr, "kernel_launch: unexpected shapes (n_in %d, out %d, ws %zu)\n", n_in, out_size, ws_size); grid = -1; return; }
        int dev = 0, cus = 0, per_cu = 0;
        if (hipGetDevice(&dev) != hipSuccess || hipDeviceGetAttribute(&cus, hipDeviceAttributeMultiprocessorCount, dev) != hipSuccess) { grid = -1; return; }
        if (hipFuncSetAttribute((const void*)hymba_fwd, hipFuncAttributeMaxDynamicSharedMemorySize, LDS_BYTES) != hipSuccess) { fprintf(stderr, "kernel_launch: hipFuncSetAttribute failed\n"); grid = -1; return; }
        if (hipOccupancyMaxActiveBlocksPerMultiprocessor(&per_cu, (const void*)hymba_fwd, NWAVES * 64, LDS_BYTES) != hipSuccess || per_cu < 1) { fprintf(stderr, "kernel_launch: occupancy query says %d\n", per_cu); per_cu = 1; }
        (void)hipGetLastError();
        grid = cus;
    }
    if (grid < 0) return;
    (void)hipMemsetAsync((char*)d_ws + WS_CTL, 0, CTL_ZERO_BYTES, stream);
    Args a{};
    for (int i = 0; i < 14; ++i) a.in[i] = (const float*)d_in[i];
    a.out = (float*)d_out; a.ws = (unsigned char*)d_ws;
#if MK_N_LAUNCHES == 1
    a.ph_lo = 0; a.ph_hi = N_PHASES;
    void* kargs[] = {&a};
    hipError_t e = hipLaunchCooperativeKernel((const void*)hymba_fwd, dim3(grid), dim3(NWAVES * 64), kargs, LDS_BYTES, stream);
    if (e != hipSuccess) fprintf(stderr, "kernel_launch: cooperative launch failed: %s (grid %d)\n", hipGetErrorString(e), grid);
#else
    for (int li = 0; li < N_PHASES; ++li) { a.ph_lo = li; a.ph_hi = li + 1; hipLaunchKernelGGL(hymba_fwd, dim3(grid), dim3(NWAVES * 64), LDS_BYTES, stream, a); }
#endif
}
```
